# Optimizing an MI355X kernel written in HIP

```python
import math
import jax
import jax.numpy as jnp
from jax import lax
import numpy as np

D_MODEL = 1024
BATCH = 4
SEQ = 4096
DEPTH = 1

D_MIX = D_MODEL
D_CONV = D_MIX // 2
D_SSM = D_MIX - D_CONV
CONV_WIDTH = 31
SSM_GROUP = 16
SSM_GROUPS = D_SSM // SSM_GROUP
SSM_STATE = 64
OUT_HEAD_DIM = 64
D_IN = 2 * D_CONV + D_SSM
D_FF = ((8 * D_MODEL // 3 + 127) // 128) * 128
FFN_RES = 0.5
EPS = 1e-6
DT_MIN = 1e-3
DT_MAX = 1e-1

kernel_name = 'hybrid_conformer_s5_encoder_layer'


def rms_norm(x, g):
    xf = x.astype(jnp.float32)
    y = xf * lax.rsqrt(jnp.mean(xf * xf, axis=-1, keepdims=True) + EPS)
    return (y * g.astype(jnp.float32)).astype(x.dtype)


def head_rms_norm(x, g, head_dim):
    b, l, d = x.shape
    xh = x.astype(jnp.float32).reshape(b, l, d // head_dim, head_dim)
    y = xh * lax.rsqrt(jnp.mean(xh * xh, axis=-1, keepdims=True) + EPS)
    return (y.reshape(b, l, d) * g.astype(jnp.float32)).astype(x.dtype)


def layer_norm(x, g, b):
    xf = x.astype(jnp.float32)
    mu = jnp.mean(xf, axis=-1, keepdims=True)
    var = jnp.mean(jnp.square(xf - mu), axis=-1, keepdims=True)
    y = (xf - mu) * lax.rsqrt(var + EPS)
    return (y * g.astype(jnp.float32) + b.astype(jnp.float32)).astype(x.dtype)


def swiglu(u, w_gate, w_up, w_down):
    return (jax.nn.silu(u @ w_gate) * (u @ w_up)) @ w_down


def depthwise_conv(v, w, b):
    rhs = w[:, None, :]
    pad = CONV_WIDTH // 2
    y = lax.conv_general_dilated(
        v, rhs, window_strides=(1,), padding=[(pad, pad)],
        dimension_numbers=('NWC', 'WIO', 'NWC'),
        feature_group_count=v.shape[-1])
    return y + b


def _linear_recurrence(e1, e2):
    a1, b1 = e1
    a2, b2 = e2
    return a1 * a2, a2 * b1 + b2


def s5_direction(u, lam_re, lam_im, log_step, b_re, b_im, c_re, c_im, reverse):
    lam = lax.complex(lam_re.astype(jnp.float32), lam_im.astype(jnp.float32))
    step = jnp.exp(log_step.astype(jnp.float32))[:, None]
    a_bar = jnp.exp(lam * step)
    b_c = lax.complex(b_re.astype(jnp.float32), b_im.astype(jnp.float32))
    b_bar = ((a_bar - 1.0) / lam)[..., None] * b_c
    bu = jnp.einsum('blgh,gph->blgp', u.astype(jnp.complex64), b_bar)
    a = jnp.broadcast_to(a_bar, bu.shape)
    _, states = lax.associative_scan(_linear_recurrence, (a, bu), axis=1, reverse=reverse)
    c_c = lax.complex(c_re.astype(jnp.float32), c_im.astype(jnp.float32))
    return jnp.real(jnp.einsum('blgp,ghp->blgh', states, c_c))


def hybrid_mixer(u, w_in, b_in, conv_w, conv_b, conv_ln_g, conv_ln_b, conv_out_g,
                 lam_re_f, lam_im_f, log_step_f, b_re_f, b_im_f, c_re_f, c_im_f,
                 lam_re_b, lam_im_b, log_step_b, b_re_b, b_im_b, c_re_b, c_im_b,
                 ssm_d, ssm_glu_w, ssm_glu_b, ssm_out_g, w_out, b_out):
    bsz, seq, _ = u.shape
    z = u @ w_in + b_in
    conv_val = z[..., :D_CONV]
    conv_gate = z[..., D_CONV:2 * D_CONV]
    ssm_in = z[..., 2 * D_CONV:]

    g = conv_val * jax.nn.sigmoid(conv_gate)
    d = depthwise_conv(g, conv_w, conv_b)
    d = jax.nn.silu(layer_norm(d, conv_ln_g, conv_ln_b))
    conv_y = head_rms_norm(d, conv_out_g, OUT_HEAD_DIM)

    s = ssm_in.astype(jnp.float32).reshape(bsz, seq, SSM_GROUPS, SSM_GROUP)
    y = (s5_direction(s, lam_re_f, lam_im_f, log_step_f, b_re_f, b_im_f, c_re_f, c_im_f, False)
         + s5_direction(s, lam_re_b, lam_im_b, log_step_b, b_re_b, b_im_b, c_re_b, c_im_b, True)
         + s * ssm_d.astype(jnp.float32).reshape(SSM_GROUPS, SSM_GROUP))
    y = jax.nn.gelu(y.reshape(bsz, seq, D_SSM).astype(u.dtype))
    y = y * jax.nn.sigmoid(y @ ssm_glu_w + ssm_glu_b)
    ssm_y = head_rms_norm(y, ssm_out_g, OUT_HEAD_DIM)

    return jnp.concatenate([conv_y, ssm_y], axis=-1) @ w_out + b_out


def setup_inputs(seed: int = 0) -> dict:
    key = jax.random.key(seed)
    ks = iter(jax.random.split(key, 64))
    f32 = jnp.float32

    def normal(shape, scale):
        return jax.random.normal(next(ks), shape, f32) * scale

    def gain(shape):
        return 1.0 + normal(shape, 0.05)

    def ssm_dir():
        lam_re = -0.5 + normal((DEPTH, SSM_GROUPS, SSM_STATE), 0.01)
        lam_im = jnp.pi * jnp.arange(SSM_STATE, dtype=f32) + normal((DEPTH, SSM_GROUPS, SSM_STATE), 0.01)
        log_step = jax.random.uniform(next(ks), (DEPTH, SSM_GROUPS), f32,
                                      minval=math.log(DT_MIN), maxval=math.log(DT_MAX))
        b_re = normal((DEPTH, SSM_GROUPS, SSM_STATE, SSM_GROUP), (2 * SSM_GROUP) ** -0.5)
        b_im = normal((DEPTH, SSM_GROUPS, SSM_STATE, SSM_GROUP), (2 * SSM_GROUP) ** -0.5)
        c_re = normal((DEPTH, SSM_GROUPS, SSM_GROUP, SSM_STATE), SSM_STATE ** -0.5)
        c_im = normal((DEPTH, SSM_GROUPS, SSM_GROUP, SSM_STATE), SSM_STATE ** -0.5)
        return lam_re, lam_im, log_step, b_re, b_im, c_re, c_im

    x = normal((BATCH, SEQ, D_MODEL), 1.0)
    inp = {}
    inp['x'] = x
    inp['ffn1_pre_g'] = gain((DEPTH, D_MODEL))
    inp['ffn1_w_gate'] = normal((DEPTH, D_MODEL, D_FF), D_MODEL ** -0.5)
    inp['ffn1_w_up'] = normal((DEPTH, D_MODEL, D_FF), D_MODEL ** -0.5)
    inp['ffn1_w_down'] = normal((DEPTH, D_FF, D_MODEL), D_FF ** -0.5)
    inp['ffn1_post_g'] = gain((DEPTH, D_MODEL))
    inp['mix_pre_g'] = gain((DEPTH, D_MODEL))
    inp['w_in'] = normal((DEPTH, D_MODEL, D_IN), D_MODEL ** -0.5)
    inp['b_in'] = normal((DEPTH, D_IN), 0.02)
    inp['conv_w'] = normal((DEPTH, CONV_WIDTH, D_CONV), CONV_WIDTH ** -0.5)
    inp['conv_b'] = normal((DEPTH, D_CONV), 0.02)
    inp['conv_ln_g'] = gain((DEPTH, D_CONV))
    inp['conv_ln_b'] = normal((DEPTH, D_CONV), 0.02)
    inp['conv_out_g'] = gain((DEPTH, D_CONV))
    (inp['lam_re_f'], inp['lam_im_f'], inp['log_step_f'], inp['b_re_f'],
     inp['b_im_f'], inp['c_re_f'], inp['c_im_f']) = ssm_dir()
    (inp['lam_re_b'], inp['lam_im_b'], inp['log_step_b'], inp['b_re_b'],
     inp['b_im_b'], inp['c_re_b'], inp['c_im_b']) = ssm_dir()
    inp['ssm_d'] = normal((DEPTH, D_SSM), 1.0)
    inp['ssm_glu_w'] = normal((DEPTH, D_SSM, D_SSM), D_SSM ** -0.5)
    inp['ssm_glu_b'] = normal((DEPTH, D_SSM), 0.02)
    inp['ssm_out_g'] = gain((DEPTH, D_SSM))
    inp['w_out'] = normal((DEPTH, D_MIX, D_MODEL), D_MIX ** -0.5)
    inp['b_out'] = normal((DEPTH, D_MODEL), 0.02)
    inp['mix_post_g'] = gain((DEPTH, D_MODEL))
    inp['ffn2_pre_g'] = gain((DEPTH, D_MODEL))
    inp['ffn2_w_gate'] = normal((DEPTH, D_MODEL, D_FF), D_MODEL ** -0.5)
    inp['ffn2_w_up'] = normal((DEPTH, D_MODEL, D_FF), D_MODEL ** -0.5)
    inp['ffn2_w_down'] = normal((DEPTH, D_FF, D_MODEL), D_FF ** -0.5)
    inp['ffn2_post_g'] = gain((DEPTH, D_MODEL))
    return inp


def reference(x, ffn1_pre_g, ffn1_w_gate, ffn1_w_up, ffn1_w_down, ffn1_post_g,
              mix_pre_g, w_in, b_in, conv_w, conv_b, conv_ln_g, conv_ln_b, conv_out_g,
              lam_re_f, lam_im_f, log_step_f, b_re_f, b_im_f, c_re_f, c_im_f,
              lam_re_b, lam_im_b, log_step_b, b_re_b, b_im_b, c_re_b, c_im_b,
              ssm_d, ssm_glu_w, ssm_glu_b, ssm_out_g, w_out, b_out, mix_post_g,
              ffn2_pre_g, ffn2_w_gate, ffn2_w_up, ffn2_w_down, ffn2_post_g):
    h = x
    for l in range(DEPTH):
        f = swiglu(rms_norm(h, ffn1_pre_g[l]), ffn1_w_gate[l], ffn1_w_up[l], ffn1_w_down[l])
        h = h + FFN_RES * rms_norm(f, ffn1_post_g[l])
        m = hybrid_mixer(rms_norm(h, mix_pre_g[l]), w_in[l], b_in[l],
                         conv_w[l], conv_b[l], conv_ln_g[l], conv_ln_b[l], conv_out_g[l],
                         lam_re_f[l], lam_im_f[l], log_step_f[l], b_re_f[l], b_im_f[l], c_re_f[l], c_im_f[l],
                         lam_re_b[l], lam_im_b[l], log_step_b[l], b_re_b[l], b_im_b[l], c_re_b[l], c_im_b[l],
                         ssm_d[l], ssm_glu_w[l], ssm_glu_b[l], ssm_out_g[l], w_out[l], b_out[l])
        h = h + rms_norm(m, mix_post_g[l])
        f = swiglu(rms_norm(h, ffn2_pre_g[l]), ffn2_w_gate[l], ffn2_w_up[l], ffn2_w_down[l])
        h = h + FFN_RES * rms_norm(f, ffn2_post_g[l])
    return h
```

```cpp
#include <hip/hip_runtime.h>
#include <hip/hip_cooperative_groups.h>
#include <cstdio>
namespace cg = cooperative_groups;


#define LAS __attribute__((address_space(3)))
typedef unsigned short bf16_t;
typedef short bf16x8 __attribute__((ext_vector_type(8)));
typedef float f32x4 __attribute__((ext_vector_type(4)));
typedef float f32x2 __attribute__((ext_vector_type(2)));
typedef unsigned u32x4 __attribute__((ext_vector_type(4)));
typedef unsigned u32x2 __attribute__((ext_vector_type(2)));

constexpr int T = 16384, D = 1024, DFF = 2816, DIN = 1536, DC = 512, DS = 512, SEQ = 4096;
constexpr int NPH = 14;
constexpr int LDS_CTL = 132 * 1024;
constexpr float EPS = 1e-6f;

constexpr size_t SZ_WGU = (size_t)2 * DFF * D * 2, SZ_WD = (size_t)D * DFF * 2;
constexpr size_t WS_WGU1 = 0, WS_WD1 = WS_WGU1 + SZ_WGU, WS_WGU2 = WS_WGU1, WS_WD2 = WS_WD1;
constexpr size_t WS_HB = WS_WD1 + SZ_WD;
constexpr size_t WS_WIN = WS_HB + (size_t)T * D * 2, WS_WGLU = WS_WIN + (size_t)DIN * D * 2, WS_WOUT = WS_WGLU + (size_t)DS * DS * 2;
constexpr size_t WS_B2 = WS_WOUT + (size_t)D * D * 2;
constexpr size_t WS_WST = WS_B2 + (size_t)16384 * 768 * 2;
constexpr size_t WS_KTAB = WS_WST + (size_t)8192 * 512 * 2;
constexpr size_t WS_ADEC = WS_KTAB + (size_t)64 * 32 * 256 * 4;
constexpr size_t WS_U = WS_ADEC + (size_t)64 * 64 * 2 * 4;
constexpr size_t WS_F = WS_U + (size_t)T * D * 2;
constexpr size_t WS_ACT = WS_F + (size_t)T * D * 2;
constexpr size_t WS_GC = WS_ACT;
constexpr size_t WS_A2 = WS_GC + (size_t)T * DC * 2;
constexpr size_t WS_X = WS_A2 + (size_t)16384 * 768 * 2;
constexpr size_t WS_YG = WS_X + (size_t)16384 * 256 * 4;
constexpr size_t WS_BAR = WS_ACT + (size_t)T * DFF * 2;
constexpr size_t WS_SS = WS_BAR + 16384;
constexpr size_t WS_END = WS_SS + (size_t)5 * T * 4;
constexpr size_t ZERO_BYTES = WS_END - WS_BAR;
static_assert(WS_YG + (size_t)T * DS * 2 <= WS_BAR, "mixer aliases fit");
static_assert(WS_END <= (size_t)256 * 1024 * 1024, "workspace");

__device__ __forceinline__ unsigned pk2(float lo, float hi) { unsigned r; asm volatile("v_cvt_pk_bf16_f32 %0, %1, %2" : "=v"(r) : "v"(lo), "v"(hi)); return r; }
__device__ __forceinline__ float bf_lo(unsigned v) { return __uint_as_float(v << 16); }
__device__ __forceinline__ float bf_hi(unsigned v) { return __uint_as_float(v & 0xffff0000u); }
__device__ __forceinline__ float sigmoid_f(float x) { return __builtin_amdgcn_rcpf(1.0f + __builtin_amdgcn_exp2f(-1.4426950408889634f * x)); }
__device__ __forceinline__ float silu_f(float x) { return x * sigmoid_f(x); }
__device__ __forceinline__ float gelu_tanh_f(float x) { return x * sigmoid_f(1.5957691216057308f * (x + 0.044715f * x * x * x)); }
template <int CTRL> __device__ __forceinline__ float dpp_f(float v) { return __builtin_bit_cast(float, __builtin_amdgcn_update_dpp(0, __builtin_bit_cast(int, v), CTRL, 0xF, 0xF, true)); }
__device__ __forceinline__ float sum8_dpp(float v) {
    v += dpp_f<0xB1>(v);
    v += dpp_f<0x4E>(v);
    v += dpp_f<0x141>(v);
    return v;
}
__device__ __forceinline__ float wave_sum(float v) {
    v = sum8_dpp(v);
    v += dpp_f<0x140>(v);
    const int iv = __builtin_bit_cast(int, v);
    const float r0 = __builtin_bit_cast(float, __builtin_amdgcn_readlane(iv, 0)), r1 = __builtin_bit_cast(float, __builtin_amdgcn_readlane(iv, 16));
    const float r2 = __builtin_bit_cast(float, __builtin_amdgcn_readlane(iv, 32)), r3 = __builtin_bit_cast(float, __builtin_amdgcn_readlane(iv, 48));
    return (r0 + r1) + (r2 + r3);
}

#define XB_TMO      128
#define XB_XCNT(j)  (256  + 64 * (j))
#define XB_XSUB(j)  (1280 + 64 * (j))
#define XB_XGEN(j)  (2304 + 64 * (j))
#define XB_TOP      3328
#define XB_TOPGEN   3392
#define XCD_BAR_WORDS 3456
#define XB_SPIN_CAP (1u << 18)
__device__ __forceinline__ unsigned xb_ld(unsigned* p)              { return __hip_atomic_load(p, __ATOMIC_RELAXED, __HIP_MEMORY_SCOPE_AGENT); }
__device__ __forceinline__ unsigned xb_add(unsigned* p, unsigned v) { return __hip_atomic_fetch_add(p, v, __ATOMIC_RELAXED, __HIP_MEMORY_SCOPE_AGENT); }
__device__ __forceinline__ unsigned xb_xcc_id() { return (unsigned)__builtin_amdgcn_s_getreg((3 << 11) | 20) & 0xFu; }
#define XB_SPIN(cond, bar) do { unsigned _sp = 0; while (cond) { __builtin_amdgcn_s_sleep(1); \
    if ((++_sp & 255u) == 0u) { if (xb_ld(&(bar)[XB_TMO])) break; if (_sp > XB_SPIN_CAP) { atomicAdd(&(bar)[XB_TMO], 1u); break; } } } } while (0)
struct XcdBarrier { unsigned* bar; unsigned x; volatile LAS unsigned* st; };
__device__ __forceinline__ XcdBarrier xcd_barrier_post(unsigned* bar, volatile LAS unsigned* st) {
    XcdBarrier b; b.bar = bar; b.x = xb_xcc_id(); b.st = st;
    if (threadIdx.x == 0) (void)xb_add(&bar[XB_XCNT(b.x)], 1u);
    return b;
}
__device__ __forceinline__ void xcd_barrier_complete(unsigned* bar, unsigned x, unsigned& nloc, unsigned& nx) {
    const unsigned G = gridDim.x * gridDim.y * gridDim.z;
    unsigned sum, cnt, mine, sp = 0u;
    for (;;) {
        sum = 0u; cnt = 0u; mine = 0u;
#pragma unroll
        for (unsigned j = 0; j < 16; ++j) { const unsigned c = xb_ld(&bar[XB_XCNT(j)]); sum += c; cnt += (c > 0u) ? 1u : 0u; mine = (j == x) ? c : mine; }
        if (sum == G) break;
        __builtin_amdgcn_s_sleep(1);
        if ((++sp & 255u) == 0u) { if (xb_ld(&bar[XB_TMO])) break; if (sp > XB_SPIN_CAP) { atomicAdd(&bar[XB_TMO], 1u); break; } }
    }
    nloc = mine > 0u ? mine : 1u; nx = cnt > 0u ? cnt : 1u;
}
__device__ __forceinline__ void xcd_barrier(const XcdBarrier& b) {
    asm volatile("s_waitcnt vmcnt(0)" ::: "memory");
    __syncthreads();
    if (threadIdx.x == 0) {
        unsigned* bar = b.bar;
        __builtin_amdgcn_s_waitcnt(0);
        unsigned nloc = b.st[0], nx = b.st[1];
        if (nloc == 0u) { xcd_barrier_complete(bar, b.x, nloc, nx); b.st[0] = nloc; b.st[1] = nx; }
        const unsigned old = xb_add(&bar[XB_XSUB(b.x)], 1u);
        const unsigned gen = old / nloc;
        if (old + 1u == (gen + 1u) * nloc) {
            __builtin_amdgcn_fence(__ATOMIC_RELEASE, "agent");
            asm volatile("s_waitcnt vmcnt(0)" ::: "memory");
            const unsigned og = xb_add(&bar[XB_TOP], 1u);
            const unsigned tg = og / nx;
            if (og + 1u == (tg + 1u) * nx) xb_add(&bar[XB_TOPGEN], 1u);
            else XB_SPIN(xb_ld(&bar[XB_TOPGEN]) == tg, bar);
            __builtin_amdgcn_fence(__ATOMIC_ACQUIRE, "agent");
            xb_add(&bar[XB_XGEN(b.x)], 1u);
            asm volatile("s_waitcnt vmcnt(0)" ::: "memory");
        } else {
            XB_SPIN(xb_ld(&bar[XB_XGEN(b.x)]) == gen, bar);
            __builtin_amdgcn_fence(__ATOMIC_ACQUIRE, "agent");
            asm volatile("s_waitcnt vmcnt(0)" ::: "memory");
        }
    }
    __syncthreads();
}

namespace pg8 {
constexpr int BM = 256, BK = 64, HALF = 128, HTB = HALF * BK * 2, STAGE_BYTES = 8 * HTB, NXCD = 8, WGM = 8;
__host__ __device__ __forceinline__ int lds_byte(int r, int c) { const int st = (r >> 4) * 2 + (c >> 5), rr = r & 15, cc = c & 31, ob = rr * 64 + cc * 2; return st * 1024 + (ob ^ (((ob >> 9) & 1) << 5)); }
__host__ __device__ __forceinline__ void stage_rc(int b, int& R, int& C) { const int st = b / 1024, sb = b % 1024, swz = sb ^ (((sb >> 9) & 1) << 5); R = (st >> 1) * 16 + swz / 64; C = (st & 1) * 32 + (swz % 64) / 2; }
__host__ __device__ __forceinline__ int perm32(int rho) { const int n = rho >> 4, i = rho & 15; return 8 * (i >> 2) + 4 * n + (i & 3); }

struct Unit { int pm, pn, pb; };
struct Gemm { const bf16_t* A; const bf16_t* Bt; int lda, ldb, K; };

struct Sched {
    int mode, nM, nN, nwg, G, c;
    __device__ __forceinline__ void init(int mode_, int M, int N, int G_, int c_) { mode = mode_; nM = M / BM; nN = N / BM; nwg = nM * nN; G = G_; c = c_; }
    __device__ __forceinline__ bool next(int i, Unit& u) const {
        const long L = (long)i * G + c;
        if (mode == 1) { if (L >= 64) return false; u.pm = (int)L; u.pn = 0; u.pb = (int)L >> 1; return true; }
        if (mode == 2) { if (L >= 128) return false; u.pm = (int)L >> 1; u.pn = (int)L & 1; u.pb = (u.pm >> 1) * 2 + u.pn; return true; }
        if (L >= nwg) return false;
        int wgid = (int)L; { const int q = nwg / NXCD, r = nwg % NXCD, xcd = wgid % NXCD, off = wgid / NXCD; wgid = (xcd < r ? xcd * (q + 1) : r * (q + 1) + (xcd - r) * q) + off; }
        const int nig = WGM * nN, gid = wgid / nig, fm = gid * WGM, gsz = (nM - fm) < WGM ? (nM - fm) : WGM;
        u.pm = fm + ((wgid % nig) % gsz); u.pn = (wgid % nig) / gsz; u.pb = u.pn; return true;
    }
};

typedef f32x4 Acc[2][2][4][2];

template <class Epi>
__device__ __forceinline__ void gemm_phase(LAS unsigned char* lds, const Gemm g, const Sched& S, const Epi& E) {
    const int tid = threadIdx.x, wid = __builtin_amdgcn_readfirstlane(tid >> 6), lane = tid & 63, wr = wid >> 2, wc = wid & 3, fr = lane & 15, fq = lane >> 4;
    const int K = g.K, nt = K / BK;
    unsigned voffA[2], voffB[2];
#pragma unroll
    for (int i = 0; i < 2; ++i) { int R, C; stage_rc(tid * 16 + i * 8192, R, C); const int Rb = Epi::PERM ? ((R & ~31) + perm32(R & 31)) : R;
        voffA[i] = (unsigned)(R * g.lda + C) * 2u; voffB[i] = (unsigned)(Rb * g.ldb + C) * 2u; }
    const size_t kstep = (size_t)(BK * 2);
    const size_t hstepA = (size_t)HALF * g.lda * 2, hstepB = (size_t)HALF * g.ldb * 2;
    const size_t tstepA = 2 * hstepA, tstepB = 2 * hstepB;
    const unsigned ldsw = (unsigned)wid * 1024u;
    const int aoff = lds_byte(wr * 64 + fr, fq * 8), boff = lds_byte(wc * 32 + fr, fq * 8);
#define PG8_SA(b, h) (((b) * 2 + (h)) * HTB)
#define PG8_SB(b, h) ((4 + (b) * 2 + (h)) * HTB)
#define PG8_STAGE(bufoff, gbase, voff) do { _Pragma("unroll") for (int _i = 0; _i < 2; ++_i) \
        __builtin_amdgcn_global_load_lds((const unsigned*)((const char*)(gbase) + (voff)[_i]), (LAS unsigned*)(lds + (bufoff) + ldsw + _i * 8192), 16, 0, 0); } while (0)
#define PG8_LDA(dst, b, h) do { _Pragma("unroll") for (int m = 0; m < 4; ++m) _Pragma("unroll") for (int k = 0; k < 2; ++k) dst[m][k] = *(const LAS bf16x8*)(lds + PG8_SA(b, h) + aoff + m * 2048 + k * 1024); } while (0)
#define PG8_LDB(dst, b, h) do { _Pragma("unroll") for (int n = 0; n < 2; ++n) _Pragma("unroll") for (int k = 0; k < 2; ++k) dst[n][k] = *(const LAS bf16x8*)(lds + PG8_SB(b, h) + boff + n * 2048 + k * 1024); } while (0)
#define PG8_MMA(ai, bj, At, Bt) do { __builtin_amdgcn_s_setprio(1); _Pragma("unroll") for (int m = 0; m < 4; ++m) _Pragma("unroll") for (int n = 0; n < 2; ++n) _Pragma("unroll") for (int k = 0; k < 2; ++k) \
        acc[ai][bj][m][n] = __builtin_amdgcn_mfma_f32_16x16x32_bf16(Bt[n][k], At[m][k], acc[ai][bj][m][n], 0, 0, 0); __builtin_amdgcn_s_setprio(0); } while (0)
#define PG8_WAIT_V(n) asm volatile("s_waitcnt vmcnt(" #n ")" ::: "memory")
#define PG8_WAIT_L(n) asm volatile("s_waitcnt lgkmcnt(" #n ")" ::: "memory")
#define PG8_BAR __builtin_amdgcn_s_barrier()
#define PG8_SCHED __builtin_amdgcn_sched_barrier(0)
    Unit cur, nxt; int ui = 0;
    if (!S.next(0, cur)) return;
    Acc acc;
#pragma unroll
    for (int a = 0; a < 2; ++a)
#pragma unroll
        for (int b = 0; b < 2; ++b)
#pragma unroll
            for (int m = 0; m < 4; ++m)
#pragma unroll
                for (int n = 0; n < 2; ++n) acc[a][b][m][n] = (f32x4){0.f, 0.f, 0.f, 0.f};
    bf16x8 At[4][2], B0[2][2], B1[2][2];
    const char* cA = (const char*)g.A + (size_t)cur.pm * tstepA; const char* cB = (const char*)g.Bt + (size_t)cur.pb * tstepB;
    PG8_STAGE(PG8_SB(0, 0), cB, voffB); PG8_STAGE(PG8_SA(0, 0), cA, voffA); PG8_STAGE(PG8_SB(0, 1), cB + hstepB, voffB); PG8_STAGE(PG8_SA(0, 1), cA + hstepA, voffA);
    if (wr == 1) PG8_BAR;
    PG8_WAIT_V(4); PG8_BAR;
    PG8_STAGE(PG8_SB(1, 0), cB + kstep, voffB); PG8_STAGE(PG8_SA(1, 0), cA + kstep, voffA); PG8_STAGE(PG8_SB(1, 1), cB + hstepB + kstep, voffB);
    PG8_WAIT_V(6); PG8_BAR;
    for (;;) {
        const bool has_next = S.next(ui + 1, nxt);
        const char* nA = has_next ? (const char*)g.A + (size_t)nxt.pm * tstepA : cA; const char* nB = has_next ? (const char*)g.Bt + (size_t)nxt.pb * tstepB : cB;
        for (int t = 0; t < nt; t += 2) {
            const bool last = (t == nt - 2);
            const char* a1 = cA + (size_t)(t + 1) * kstep;
            const char* a2 = last ? nA : cA + (size_t)(t + 2) * kstep; const char* b2 = last ? nB : cB + (size_t)(t + 2) * kstep;
            const char* a3 = a2 + kstep; const char* b3 = b2 + kstep;
            PG8_LDB(B0, 0, 0); PG8_SCHED; PG8_LDA(At, 0, 0); PG8_STAGE(PG8_SA(1, 1), a1 + hstepA, voffA);
            PG8_WAIT_L(8); PG8_BAR; PG8_WAIT_L(0); PG8_MMA(0, 0, At, B0); PG8_BAR; PG8_SCHED;
            PG8_LDB(B1, 0, 1); PG8_STAGE(PG8_SB(0, 0), b2, voffB);
            PG8_BAR; PG8_WAIT_L(0); PG8_MMA(0, 1, At, B1); PG8_BAR;
            PG8_LDA(At, 0, 1); PG8_STAGE(PG8_SA(0, 0), a2, voffA);
            PG8_BAR; PG8_WAIT_L(0); PG8_MMA(1, 0, At, B0); PG8_BAR; PG8_SCHED;
            PG8_STAGE(PG8_SB(0, 1), b2 + hstepB, voffB);
            PG8_WAIT_V(6); PG8_BAR; PG8_MMA(1, 1, At, B1); PG8_BAR;
            PG8_LDB(B0, 1, 0); PG8_SCHED; PG8_LDA(At, 1, 0); PG8_STAGE(PG8_SA(0, 1), a2 + hstepA, voffA);
            PG8_WAIT_L(8); PG8_BAR; PG8_WAIT_L(0); PG8_MMA(0, 0, At, B0); PG8_BAR; PG8_SCHED;
            PG8_LDB(B1, 1, 1); PG8_STAGE(PG8_SB(1, 0), b3, voffB);
            PG8_BAR; PG8_WAIT_L(0); PG8_MMA(0, 1, At, B1); PG8_BAR;
            PG8_LDA(At, 1, 1); PG8_STAGE(PG8_SA(1, 0), a3, voffA);
            PG8_BAR; PG8_WAIT_L(0); PG8_MMA(1, 0, At, B0); PG8_BAR; PG8_SCHED;
            PG8_STAGE(PG8_SB(1, 1), b3 + hstepB, voffB);
            PG8_WAIT_V(6); PG8_BAR; PG8_MMA(1, 1, At, B1); PG8_BAR;
        }
        if constexpr (!Epi::AFTER_DRAIN) E(acc, cur, wr, wc, fr, fq);
        if (!has_next) break;
#pragma unroll
        for (int a = 0; a < 2; ++a)
#pragma unroll
            for (int b = 0; b < 2; ++b)
#pragma unroll
                for (int m = 0; m < 4; ++m)
#pragma unroll
                    for (int n = 0; n < 2; ++n) acc[a][b][m][n] = (f32x4){0.f, 0.f, 0.f, 0.f};
        cur = nxt; cA = nA; cB = nB; ++ui;
    }
    PG8_WAIT_V(0);
    if (wr == 0) PG8_BAR;
    PG8_BAR;
    if constexpr (Epi::AFTER_DRAIN) E.fused(acc, cur, wr, wc, fr, fq);
#undef PG8_SA
#undef PG8_SB
#undef PG8_STAGE
#undef PG8_LDA
#undef PG8_LDB
#undef PG8_MMA
#undef PG8_WAIT_V
#undef PG8_WAIT_L
#undef PG8_BAR
#undef PG8_SCHED
}

struct EpiBf16 {
    static constexpr bool PERM = true, AFTER_DRAIN = false;
    bf16_t* O; int ldc; const float* bias;
    __device__ __forceinline__ void operator()(const Acc& acc, const Unit& u, int wr, int wc, int fr, int fq) const {
        const int row0 = u.pm * BM + wr * 64 + fr, col0 = u.pn * BM + wc * 32 + 8 * fq;
        f32x4 bv[2][2];
#pragma unroll
        for (int bj = 0; bj < 2; ++bj)
#pragma unroll
            for (int n = 0; n < 2; ++n) bv[bj][n] = bias ? *(const f32x4*)(bias + col0 + bj * HALF + 4 * n) : (f32x4){0.f, 0.f, 0.f, 0.f};
#pragma unroll
        for (int ai = 0; ai < 2; ++ai)
#pragma unroll
            for (int m = 0; m < 4; ++m) { bf16_t* rowp = O + (size_t)(row0 + ai * HALF + m * 16) * ldc + col0;
#pragma unroll
                for (int bj = 0; bj < 2; ++bj) { const f32x4 v0 = acc[ai][bj][m][0] + bv[bj][0], v1 = acc[ai][bj][m][1] + bv[bj][1];
                    u32x4 w; w.x = pk2(v0[0], v0[1]); w.y = pk2(v0[2], v0[3]); w.z = pk2(v1[0], v1[1]); w.w = pk2(v1[2], v1[3]);
                    *(u32x4*)(rowp + bj * HALF) = w; } }
    }
};
struct EpiF32 {
    static constexpr bool PERM = false, AFTER_DRAIN = false;
    float* C; int ldc;
    __device__ __forceinline__ void operator()(const Acc& acc, const Unit& u, int wr, int wc, int fr, int fq) const {
        const int row0 = u.pm * BM + wr * 64 + fr, col0 = u.pn * BM + wc * 32 + 4 * fq;
#pragma unroll
        for (int ai = 0; ai < 2; ++ai)
#pragma unroll
            for (int m = 0; m < 4; ++m) { float* rowp = C + (size_t)(row0 + ai * HALF + m * 16) * ldc + col0;
#pragma unroll
                for (int bj = 0; bj < 2; ++bj)
#pragma unroll
                    for (int n = 0; n < 2; ++n) *(f32x4*)(rowp + bj * HALF + n * 16) = acc[ai][bj][m][n]; }
    }
};
struct EpiXScan {
    static constexpr bool PERM = false, AFTER_DRAIN = true;
    LAS unsigned char* lds; const float* adec; bf16_t* A2;
    __device__ __forceinline__ void operator()(const Acc&, const Unit&, int, int, int, int) const {}
    __device__ __forceinline__ void fused(Acc& acc, const Unit& u, int wr, int wc, int fr, int fq) const {
        constexpr int PITCH = 520;
#pragma unroll
        for (int ai = 0; ai < 2; ++ai)
#pragma unroll
            for (int m = 0; m < 4; ++m) { const int r = ai * HALF + wr * 64 + m * 16 + fr;
#pragma unroll
                for (int bj = 0; bj < 2; ++bj)
#pragma unroll
                    for (int n = 0; n < 2; ++n) { const int c = bj * HALF + wc * 32 + n * 16 + 4 * fq; const f32x4 v = acc[ai][bj][m][n];
                        u32x2 w; w.x = pk2(v[0], v[1]); w.y = pk2(v[2], v[3]); *(LAS u32x2*)(lds + r * PITCH + c * 2) = w; } }
        __syncthreads();
        const int wave = threadIdx.x >> 6, lane = threadIdx.x & 63;
        if (wave < 4) {
            const int bsel = wave >> 1, dir = wave & 1, g = u.pm >> 1, b = 2 * (u.pm & 1) + bsel;
            const f32x2 ad = *(const f32x2*)(adec + ((g * 2 + dir) * 64 + lane) * 2);
            bf16_t* sp = A2 + (size_t)(g * 512 + b * 128) * 768 + 512 + dir * 128 + 2 * lane;
            const LAS unsigned char* xp = lds + (128 * bsel) * PITCH + (dir * 128 + 2 * lane) * 2;
            float sr = 0.f, si = 0.f;
#pragma unroll 16
            for (int k = 0; k < 128; ++k) { const int c = dir == 0 ? k : 127 - k;
                const unsigned xv = *(const LAS unsigned*)(xp + c * PITCH);
                *(unsigned*)(sp + (size_t)c * 768) = pk2(sr, si);
                const float nr = ad.x * sr - ad.y * si + bf_lo(xv), ni = ad.x * si + ad.y * sr + bf_hi(xv); sr = nr; si = ni; }
        }
    }
};
struct EpiSwiGLU {
    static constexpr bool PERM = true, AFTER_DRAIN = false;
    bf16_t* O; int ldc; const float* rowss; const LAS float* rtab; int pm0;
    __device__ __forceinline__ void operator()(const Acc& acc, const Unit& u, int wr, int wc, int fr, int fq) const {
        const int row0 = u.pm * BM + wr * 64 + fr, col0 = u.pn * HALF + wc * 32 + 8 * fq;
#pragma unroll
        for (int ai = 0; ai < 2; ++ai)
#pragma unroll
            for (int m = 0; m < 4; ++m) { const int row = row0 + ai * HALF + m * 16; bf16_t* rowp = O + (size_t)row * ldc + col0;
                const float r = !rowss ? 1.0f : (u.pm == pm0 ? rtab[row - pm0 * BM] : __builtin_amdgcn_rsqf(rowss[row] * (1.0f / D) + EPS));
                float v[8];
#pragma unroll
                for (int n = 0; n < 2; ++n)
#pragma unroll
                    for (int j = 0; j < 4; ++j) v[4 * n + j] = silu_f(acc[ai][0][m][n][j] * r) * (acc[ai][1][m][n][j] * r);
                u32x4 w; w.x = pk2(v[0], v[1]); w.y = pk2(v[2], v[3]); w.z = pk2(v[4], v[5]); w.w = pk2(v[6], v[7]);
                *(u32x4*)rowp = w; }
    }
};
struct EpiNormRes {
    static constexpr bool PERM = true, AFTER_DRAIN = true;
    const float* res_f32; const bf16_t* res_bf16; float alpha; const float* gpost; const float* bias; float* ss1; float* ss2; bf16_t* hb; float* out; const XcdBarrier* bar;
    __device__ __forceinline__ void operator()(const Acc&, const Unit&, int, int, int, int) const {}
    __device__ __forceinline__ void fused(Acc& acc, const Unit& u, int wr, int wc, int fr, int fq) const {
        const int row0 = u.pm * BM + wr * 64 + fr, col0 = u.pn * BM + wc * 32 + 8 * fq;
        if (bias) {
#pragma unroll
            for (int bj = 0; bj < 2; ++bj)
#pragma unroll
                for (int n = 0; n < 2; ++n) { const f32x4 bv = *(const f32x4*)(bias + col0 + bj * HALF + 4 * n);
#pragma unroll
                    for (int ai = 0; ai < 2; ++ai)
#pragma unroll
                        for (int m = 0; m < 4; ++m) acc[ai][bj][m][n] += bv; }
        }
#pragma unroll
        for (int ai = 0; ai < 2; ++ai)
#pragma unroll
            for (int m = 0; m < 4; ++m) { float q = 0.f;
#pragma unroll
                for (int bj = 0; bj < 2; ++bj)
#pragma unroll
                    for (int n = 0; n < 2; ++n) { const f32x4 x = acc[ai][bj][m][n]; q += (x[0] * x[0] + x[1] * x[1]) + (x[2] * x[2] + x[3] * x[3]); }
                q += __shfl_xor(q, 16); q += __shfl_xor(q, 32);
                if (fq == 0) __hip_atomic_fetch_add(ss1 + row0 + ai * HALF + m * 16, q, __ATOMIC_RELAXED, __HIP_MEMORY_SCOPE_AGENT); }
        xcd_barrier(*bar);
        f32x4 gp[2][2];
#pragma unroll
        for (int bj = 0; bj < 2; ++bj)
#pragma unroll
            for (int n = 0; n < 2; ++n) gp[bj][n] = *(const f32x4*)(gpost + col0 + bj * HALF + 4 * n);
#pragma unroll
        for (int ai = 0; ai < 2; ++ai)
#pragma unroll
            for (int m = 0; m < 4; ++m) { const int row = row0 + ai * HALF + m * 16;
                const float r = alpha * __builtin_amdgcn_rsqf(__hip_atomic_load(ss1 + row, __ATOMIC_RELAXED, __HIP_MEMORY_SCOPE_AGENT) * (1.0f / D) + EPS);
                float q = 0.f;
#pragma unroll
                for (int bj = 0; bj < 2; ++bj) { const size_t off = (size_t)row * D + col0 + bj * HALF;
                    f32x4 r0, r1;
                    if (res_bf16) { const u32x4 t = *(const u32x4*)(res_bf16 + off); r0 = (f32x4){bf_lo(t.x), bf_hi(t.x), bf_lo(t.y), bf_hi(t.y)}; r1 = (f32x4){bf_lo(t.z), bf_hi(t.z), bf_lo(t.w), bf_hi(t.w)}; }
                    else { r0 = *(const f32x4*)(res_f32 + off); r1 = *(const f32x4*)(res_f32 + off + 4); }
                    const f32x4 h0 = r0 + acc[ai][bj][m][0] * r * gp[bj][0], h1 = r1 + acc[ai][bj][m][1] * r * gp[bj][1];
                    q += (h0[0] * h0[0] + h0[1] * h0[1]) + (h0[2] * h0[2] + h0[3] * h0[3]) + (h1[0] * h1[0] + h1[1] * h1[1]) + (h1[2] * h1[2] + h1[3] * h1[3]);
                    if (hb) { u32x4 w; w.x = pk2(h0[0], h0[1]); w.y = pk2(h0[2], h0[3]); w.z = pk2(h1[0], h1[1]); w.w = pk2(h1[2], h1[3]); *(u32x4*)(hb + off) = w; }
                    else { *(f32x4*)(out + off) = h0; *(f32x4*)(out + off + 4) = h1; } }
                if (ss2) { q += __shfl_xor(q, 16); q += __shfl_xor(q, 32);
                    if (fq == 0) __hip_atomic_fetch_add(ss2 + row, q, __ATOMIC_RELAXED, __HIP_MEMORY_SCOPE_AGENT); } }
    }
};
struct EpiWin {
    static constexpr bool PERM = true, AFTER_DRAIN = false;
    bf16_t* GC; bf16_t* A2; const float* bias; const float* rowss; const LAS float* rtab; int pm0;
    __device__ __forceinline__ void operator()(const Acc& acc, const Unit& u, int wr, int wc, int fr, int fq) const {
        const int row0 = u.pm * BM + wr * 64 + fr;
        if (u.pn < 4) {
            const int col0 = u.pn * HALF + wc * 32 + 8 * fq;
            f32x4 bvv[2], bvg[2];
#pragma unroll
            for (int n = 0; n < 2; ++n) { bvv[n] = *(const f32x4*)(bias + col0 + 4 * n); bvg[n] = *(const f32x4*)(bias + 512 + col0 + 4 * n); }
#pragma unroll
            for (int ai = 0; ai < 2; ++ai)
#pragma unroll
                for (int m = 0; m < 4; ++m) { const int row = row0 + ai * HALF + m * 16; bf16_t* rowp = GC + (size_t)row * DC + col0;
                    const float r = u.pm == pm0 ? rtab[row - pm0 * BM] : __builtin_amdgcn_rsqf(rowss[row] * (1.0f / D) + EPS);
                    float v[8];
#pragma unroll
                    for (int n = 0; n < 2; ++n)
#pragma unroll
                        for (int j = 0; j < 4; ++j) v[4 * n + j] = (acc[ai][0][m][n][j] * r + bvv[n][j]) * sigmoid_f(acc[ai][1][m][n][j] * r + bvg[n][j]);
                    u32x4 w; w.x = pk2(v[0], v[1]); w.y = pk2(v[2], v[3]); w.z = pk2(v[4], v[5]); w.w = pk2(v[6], v[7]);
                    *(u32x4*)rowp = w; }
        } else {
#pragma unroll
            for (int bj = 0; bj < 2; ++bj) {
                const int s = (u.pn - 4) * BM + bj * HALF + wc * 32 + 8 * fq;
                const int gg = s >> 4, h0 = s & 15;
                const f32x4 b0 = *(const f32x4*)(bias + 1024 + s), b1 = *(const f32x4*)(bias + 1024 + s + 4);
#pragma unroll
                for (int ai = 0; ai < 2; ++ai)
#pragma unroll
                    for (int m = 0; m < 4; ++m) { const int t = row0 + ai * HALF + m * 16;
                        const float r = u.pm == pm0 ? rtab[t - pm0 * BM] : __builtin_amdgcn_rsqf(rowss[t] * (1.0f / D) + EPS);
                        const f32x4 v0 = acc[ai][bj][m][0] * r + b0, v1 = acc[ai][bj][m][1] * r + b1;
                        u32x4 w; w.x = pk2(v0[0], v0[1]); w.y = pk2(v0[2], v0[3]); w.z = pk2(v1[0], v1[1]); w.w = pk2(v1[2], v1[3]);
                        *(u32x4*)(A2 + ((size_t)(gg * 512 + (t >> 5)) * 768 + (t & 31) * 16 + h0)) = w; }
            }
        }
    }
};
struct EpiS2 {
    static constexpr bool PERM = true, AFTER_DRAIN = false;
    bf16_t* YG;
    __device__ __forceinline__ void operator()(const Acc& acc, const Unit& u, int wr, int wc, int fr, int fq) const {
        const int row0 = u.pm * BM + wr * 64 + fr;
#pragma unroll
        for (int bj = 0; bj < 2; ++bj) {
            const int col = u.pn * BM + bj * HALF + wc * 32 + 8 * fq, l = col >> 4, h0 = col & 15;
#pragma unroll
            for (int ai = 0; ai < 2; ++ai)
#pragma unroll
                for (int m = 0; m < 4; ++m) { const int row = row0 + ai * HALF + m * 16, gg = row >> 9, chunk = row & 511;
                    float v[8];
#pragma unroll
                    for (int n = 0; n < 2; ++n)
#pragma unroll
                        for (int j = 0; j < 4; ++j) v[4 * n + j] = gelu_tanh_f(acc[ai][bj][m][n][j]);
                    u32x4 w; w.x = pk2(v[0], v[1]); w.y = pk2(v[2], v[3]); w.z = pk2(v[4], v[5]); w.w = pk2(v[6], v[7]);
                    *(u32x4*)(YG + ((size_t)(chunk * 32 + l) * DS + gg * 16 + h0)) = w; }
        }
    }
};
struct EpiGlu {
    static constexpr bool PERM = true, AFTER_DRAIN = false;
    const bf16_t* YG; bf16_t* CAT; const float* bias; const float* og;
    __device__ __forceinline__ void operator()(const Acc& acc, const Unit& u, int wr, int wc, int fr, int fq) const {
        const int row0 = u.pm * BM + wr * 64 + fr, hl = u.pn * BM + wc * 64 + 8 * fq;
        f32x4 bz[2][2], gz[2][2];
#pragma unroll
        for (int bj = 0; bj < 2; ++bj)
#pragma unroll
            for (int n = 0; n < 2; ++n) { bz[bj][n] = *(const f32x4*)(bias + hl + 32 * bj + 4 * n); gz[bj][n] = *(const f32x4*)(og + hl + 32 * bj + 4 * n); }
#pragma unroll
        for (int ai = 0; ai < 2; ++ai)
#pragma unroll
            for (int m = 0; m < 4; ++m) { const int row = row0 + ai * HALF + m * 16;
                float v[2][8]; float ss = 0.f;
#pragma unroll
                for (int bj = 0; bj < 2; ++bj) { const u32x4 yv = *(const u32x4*)(YG + (size_t)row * DS + hl + 32 * bj);
                    const float y[8] = {bf_lo(yv.x), bf_hi(yv.x), bf_lo(yv.y), bf_hi(yv.y), bf_lo(yv.z), bf_hi(yv.z), bf_lo(yv.w), bf_hi(yv.w)};
#pragma unroll
                    for (int n = 0; n < 2; ++n)
#pragma unroll
                        for (int j = 0; j < 4; ++j) { const float z = acc[ai][bj][m][n][j] + bz[bj][n][j]; const float o = y[4 * n + j] * sigmoid_f(z); v[bj][4 * n + j] = o; ss += o * o; } }
                ss += __shfl_xor(ss, 16); ss += __shfl_xor(ss, 32);
                const float r = __builtin_amdgcn_rsqf(ss * (1.0f / 64.0f) + EPS);
#pragma unroll
                for (int bj = 0; bj < 2; ++bj) { u32x4 w;
                    w.x = pk2(v[bj][0] * r * gz[bj][0][0], v[bj][1] * r * gz[bj][0][1]); w.y = pk2(v[bj][2] * r * gz[bj][0][2], v[bj][3] * r * gz[bj][0][3]);
                    w.z = pk2(v[bj][4] * r * gz[bj][1][0], v[bj][5] * r * gz[bj][1][1]); w.w = pk2(v[bj][6] * r * gz[bj][1][2], v[bj][7] * r * gz[bj][1][3]);
                    *(u32x4*)(CAT + (size_t)row * D + 512 + hl + 32 * bj) = w; } }
    }
};
}

__device__ __forceinline__ void tr_item(const float* W, int K, int N, bf16_t* WT, int k0, int n0, int drow0, const float* rg, LAS float* scr, int lane) {
    { const int kr = lane >> 3, n4 = lane & 7; f32x4 v[8];
#pragma unroll
      for (int i = 0; i < 8; ++i) v[i] = *(const f32x4*)(W + (size_t)(k0 + kr + 8 * i) * N + n0 + 4 * n4);
#pragma unroll
      for (int i = 0; i < 8; ++i) { const float gk = rg ? rg[k0 + kr + 8 * i] : 1.0f;
          LAS float* d = scr + (kr + 8 * i) * 33 + 4 * n4; d[0] = v[i].x * gk; d[1] = v[i].y * gk; d[2] = v[i].z * gk; d[3] = v[i].w * gk; } }
    asm volatile("s_waitcnt lgkmcnt(0)" ::: "memory");
    const int c = lane & 7;
#pragma unroll
    for (int j = 0; j < 4; ++j) { const int n = (lane >> 3) + 8 * j; const LAS float* s = scr + (8 * c) * 33 + n;
        u32x4 o; o.x = pk2(s[0 * 33], s[1 * 33]); o.y = pk2(s[2 * 33], s[3 * 33]); o.z = pk2(s[4 * 33], s[5 * 33]); o.w = pk2(s[6 * 33], s[7 * 33]);
        *(u32x4*)(WT + (size_t)(drow0 + n) * K + k0 + 8 * c) = o; }
    asm volatile("s_waitcnt lgkmcnt(0)" ::: "memory");
}
__device__ __forceinline__ int drow_of(int mode, int n0) {
    if (mode == 1) return 256 * (n0 >> 7) + (n0 & 127);
    if (mode == 2) return 256 * (n0 >> 7) + 128 + (n0 & 127);
    if (mode == 3) { if (n0 < 512) return 256 * (n0 >> 7) + (n0 & 127); if (n0 < 1024) { const int n1 = n0 - 512; return 256 * (n1 >> 7) + 128 + (n1 & 127); } return n0; }
    if (mode == 4) { const int pn = n0 >> 8, r = n0 & 255, wc = r >> 6, bj = (r & 63) >> 5; return 256 * pn + 128 * bj + 32 * wc; }
    return n0;
}
__device__ __forceinline__ void tr_matrix_item(const float* W, int K, int N, bf16_t* WT, int mode, const float* rg, int item, LAS float* scr, int lane) {
    const int nblk = N / 32, kb = item / nblk, nb = item % nblk;
    tr_item(W, K, N, WT, 64 * kb, 32 * nb, drow_of(mode, 32 * nb), rg, scr, lane);
}

struct TrDesc { const float* W; bf16_t* WT; const float* rg; int K, N, mode, end; };
__device__ __forceinline__ void set_desc(LAS TrDesc* d, const float* W, bf16_t* WT, int K, int N, int mode, int end, const float* rg = nullptr) { d->W = W; d->WT = WT; d->rg = rg; d->K = K; d->N = N; d->mode = mode; d->end = end; }
__device__ __forceinline__ void tr_range(const LAS TrDesc* desc, int kfirst, int item_lo, int item_hi, int w0, int wstride, LAS float* scr, int lane) {
    for (int it = item_lo + w0; it < item_hi; it += wstride) {
        int k = kfirst; while (it >= desc[k].end) ++k;
        k = __builtin_amdgcn_readfirstlane(k);
        const int base = k ? desc[k - 1].end : 0;
        const unsigned long long wq = (unsigned long long)desc[k].W, tq = (unsigned long long)desc[k].WT, gq = (unsigned long long)desc[k].rg;
        const float* rg = (const float*)(((unsigned long long)(unsigned)__builtin_amdgcn_readfirstlane((int)(gq >> 32)) << 32) | (unsigned)__builtin_amdgcn_readfirstlane((int)gq));
        const float* W = (const float*)(((unsigned long long)(unsigned)__builtin_amdgcn_readfirstlane((int)(wq >> 32)) << 32) | (unsigned)__builtin_amdgcn_readfirstlane((int)wq));
        bf16_t* WT = (bf16_t*)(((unsigned long long)(unsigned)__builtin_amdgcn_readfirstlane((int)(tq >> 32)) << 32) | (unsigned)__builtin_amdgcn_readfirstlane((int)tq));
        const int K = __builtin_amdgcn_readfirstlane(desc[k].K), N = __builtin_amdgcn_readfirstlane(desc[k].N), mode = __builtin_amdgcn_readfirstlane(desc[k].mode);
        tr_matrix_item(W, K, N, WT, mode, rg, it - __builtin_amdgcn_readfirstlane(base), scr, lane);
    }
}

__device__ __forceinline__ void norm_rows(const float* x, const float* gpre, bf16_t* uout, int gw, int NGW, int lane) {
    for (int m = gw; m < T; m += 2 * NGW) {
        const int m2 = m + NGW; const bool has2 = m2 < T; const int mm2 = has2 ? m2 : m;
        const f32x4* r1 = (const f32x4*)(x + (size_t)m * D) + lane; const f32x4* r2 = (const f32x4*)(x + (size_t)mm2 * D) + lane;
        f32x4 h1[4], h2[4]; float s1 = 0.f, s2 = 0.f;
#pragma unroll
        for (int j = 0; j < 4; ++j) { h1[j] = r1[64 * j]; h2[j] = r2[64 * j]; }
#pragma unroll
        for (int j = 0; j < 4; ++j) { s1 += (h1[j].x * h1[j].x + h1[j].y * h1[j].y) + (h1[j].z * h1[j].z + h1[j].w * h1[j].w); s2 += (h2[j].x * h2[j].x + h2[j].y * h2[j].y) + (h2[j].z * h2[j].z + h2[j].w * h2[j].w); }
#pragma unroll
        for (int o = 1; o < 64; o <<= 1) { s1 += __shfl_xor(s1, o); s2 += __shfl_xor(s2, o); }
        const float q1 = 1.0f / sqrtf(s1 * (1.0f / D) + EPS), q2 = 1.0f / sqrtf(s2 * (1.0f / D) + EPS);
        u32x2* u1 = (u32x2*)(uout + (size_t)m * D) + lane; u32x2* u2 = (u32x2*)(uout + (size_t)mm2 * D) + lane;
#pragma unroll
        for (int j = 0; j < 4; ++j) { const f32x4 gp = ((const f32x4*)gpre)[lane + 64 * j]; const f32x4 o1 = h1[j] * q1 * gp, o2 = h2[j] * q2 * gp;
            u32x2 w; w.x = pk2(o1.x, o1.y); w.y = pk2(o1.z, o1.w); u1[64 * j] = w;
            if (has2) { u32x2 v; v.x = pk2(o2.x, o2.y); v.y = pk2(o2.z, o2.w); u2[64 * j] = v; } }
    }
}
template <bool RES_BF16, bool OUT_BF16, bool WRITE_U>
__device__ __forceinline__ void row_pass(const void* res, const bf16_t* f, const float* gpost, float alpha, void* hout, const float* gpre, bf16_t* uout, int gw, int NGW, int lane) {
    for (int m = gw; m < T; m += NGW) {
        f32x4 h[4];
        if (RES_BF16) { const u32x2* rr = (const u32x2*)((const bf16_t*)res + (size_t)m * D) + lane;
#pragma unroll
            for (int j = 0; j < 4; ++j) { const u32x2 q = rr[64 * j]; h[j] = (f32x4){bf_lo(q.x), bf_hi(q.x), bf_lo(q.y), bf_hi(q.y)}; } }
        else { const f32x4* rr = (const f32x4*)((const float*)res + (size_t)m * D) + lane;
#pragma unroll
            for (int j = 0; j < 4; ++j) h[j] = rr[64 * j]; }
        const u32x2* fr2 = (const u32x2*)(f + (size_t)m * D) + lane;
        f32x4 fv[4]; float ss = 0.f;
#pragma unroll
        for (int j = 0; j < 4; ++j) { const u32x2 q = fr2[64 * j]; fv[j] = (f32x4){bf_lo(q.x), bf_hi(q.x), bf_lo(q.y), bf_hi(q.y)};
            ss += (fv[j].x * fv[j].x + fv[j].y * fv[j].y) + (fv[j].z * fv[j].z + fv[j].w * fv[j].w); }
        const float rstd = alpha / sqrtf(wave_sum(ss) * (1.0f / D) + EPS);
#pragma unroll
        for (int j = 0; j < 4; ++j) { const f32x4 gp = ((const f32x4*)gpost)[lane + 64 * j]; h[j] = h[j] + fv[j] * rstd * gp; }
        if (OUT_BF16) { u32x2* ho = (u32x2*)((bf16_t*)hout + (size_t)m * D) + lane;
#pragma unroll
            for (int j = 0; j < 4; ++j) { u32x2 w; w.x = pk2(h[j].x, h[j].y); w.y = pk2(h[j].z, h[j].w); ho[64 * j] = w; } }
        else { f32x4* ho = (f32x4*)((float*)hout + (size_t)m * D) + lane;
#pragma unroll
            for (int j = 0; j < 4; ++j) ho[64 * j] = h[j]; }
        if (WRITE_U) {
            float s2 = 0.f;
#pragma unroll
            for (int j = 0; j < 4; ++j) s2 += (h[j].x * h[j].x + h[j].y * h[j].y) + (h[j].z * h[j].z + h[j].w * h[j].w);
            const float r2 = 1.0f / sqrtf(wave_sum(s2) * (1.0f / D) + EPS);
            u32x2* uo = (u32x2*)(uout + (size_t)m * D) + lane;
#pragma unroll
            for (int j = 0; j < 4; ++j) { const f32x4 gp = ((const f32x4*)gpre)[lane + 64 * j]; const f32x4 o = h[j] * r2 * gp;
                u32x2 w; w.x = pk2(o.x, o.y); w.y = pk2(o.z, o.w); uo[64 * j] = w; }
        }
    }
}

struct SsmIn { const float *lam_re, *lam_im, *log_step, *b_re, *b_im, *c_re, *c_im; };
__device__ __forceinline__ void ssm_tables_item(const SsmIn si, int g, int dir, int jq, float* Ktab, bf16_t* Wst, bf16_t* B2, float* adec, LAS float* sc, int tid) {
    LAS float* apow = sc;
    LAS float* Bb = sc + 1152;
    LAS float* Cc = sc + 1152 + 2048;
    const int gd = g * 2 + dir;
    const float step = expf(si.log_step[g]);
    for (int idx = tid; idx < 9 * 64; idx += 512) { const int jj = idx >> 6, p = idx & 63, j = 8 * jq + jj;
        const float lr = si.lam_re[g * 64 + p], li = si.lam_im[g * 64 + p];
        const float mag = expf(lr * step * (float)j);
        double th = (double)li * (double)step * (double)j; th -= 6.283185307179586 * floor(th * 0.15915494309189535);
        float s, c; sincosf((float)th, &s, &c);
        apow[idx * 2] = mag * c; apow[idx * 2 + 1] = mag * s; }
    for (int idx = tid; idx < 1024; idx += 512) { const int p = idx >> 4, h = idx & 15;
        const float lr = si.lam_re[g * 64 + p], li = si.lam_im[g * 64 + p];
        const float mag = expf(lr * step);
        double th = (double)li * (double)step; th -= 6.283185307179586 * floor(th * 0.15915494309189535);
        float s, c; sincosf((float)th, &s, &c);
        const float ar = mag * c - 1.0f, ai = mag * s;
        const float inv = 1.0f / (lr * lr + li * li);
        const float qr = (ar * lr + ai * li) * inv, qi = (ai * lr - ar * li) * inv;
        const float br = si.b_re[(g * 64 + p) * 16 + h], bi = si.b_im[(g * 64 + p) * 16 + h];
        Bb[idx * 2] = qr * br - qi * bi; Bb[idx * 2 + 1] = qr * bi + qi * br; }
    for (int idx = tid; idx < 1024; idx += 512) { Cc[idx * 2] = si.c_re[g * 1024 + idx]; Cc[idx * 2 + 1] = si.c_im[g * 1024 + idx]; }
    __syncthreads();
    LAS float* ACs = sc + 1152 + 4096;
#pragma unroll 4
    for (int r = 0; r < 16; ++r) { const int idx = tid + 512 * r, p = idx & 63, jh = idx >> 6, jj = jh >> 4, h = jh & 15;
        const float ar = apow[(jj * 64 + p) * 2], ai = apow[(jj * 64 + p) * 2 + 1], cr = Cc[(h * 64 + p) * 2], ci = Cc[(h * 64 + p) * 2 + 1];
        *(LAS f32x2*)(ACs + (jh * 65 + p) * 2) = (f32x2){ar * cr - ai * ci, ar * ci + ai * cr}; }
    __syncthreads();
    { const int jh = tid >> 2, q = tid & 3;
      f32x4 o = {0.f, 0.f, 0.f, 0.f};
#pragma unroll 8
      for (int p = 0; p < 64; ++p) { const f32x2 ac = *(const LAS f32x2*)(ACs + (jh * 65 + p) * 2);
          const f32x4 b01 = *(const LAS f32x4*)(Bb + (p * 16 + 4 * q) * 2), b23 = *(const LAS f32x4*)(Bb + (p * 16 + 4 * q + 2) * 2);
          o.x += ac.x * b01.x - ac.y * b01.y; o.y += ac.x * b01.z - ac.y * b01.w; o.z += ac.x * b23.x - ac.y * b23.y; o.w += ac.x * b23.z - ac.y * b23.w; }
      *(f32x4*)(Ktab + ((size_t)(gd * 32 + 8 * jq + (jh >> 4)) * 16 + (jh & 15)) * 16 + 4 * q) = o; }
    { const int jj = tid >> 6, p = tid & 63, j = 8 * jq + jj, lp = dir == 0 ? 31 - j : j;
      const float ar = apow[(jj * 64 + p) * 2], ai = apow[(jj * 64 + p) * 2 + 1];
      unsigned wr[8], wi[8];
#pragma unroll
      for (int q = 0; q < 8; ++q) { const f32x4 b = *(const LAS f32x4*)(Bb + (p * 16 + 2 * q) * 2);
          wr[q] = pk2(ar * b.x - ai * b.y, ar * b.z - ai * b.w); wi[q] = pk2(ar * b.y + ai * b.x, ar * b.w + ai * b.z); }
      bf16_t* o = Wst + (size_t)(g * 256 + dir * 128 + 2 * p) * 512 + lp * 16;
      *(u32x4*)o = (u32x4){wr[0], wr[1], wr[2], wr[3]}; *(u32x4*)(o + 8) = (u32x4){wr[4], wr[5], wr[6], wr[7]};
      *(u32x4*)(o + 512) = (u32x4){wi[0], wi[1], wi[2], wi[3]}; *(u32x4*)(o + 520) = (u32x4){wi[4], wi[5], wi[6], wi[7]}; }
#pragma unroll
    for (int r = 0; r < 4; ++r) { const int idx = tid + 512 * r, pq = idx & 15, h = (idx >> 4) & 15, jj = idx >> 8, e = 8 * jq + jj + 1, l = dir == 0 ? e - 1 : 32 - e;
        const f32x4 a01 = *(const LAS f32x4*)(apow + ((jj + 1) * 64 + 4 * pq) * 2), a23 = *(const LAS f32x4*)(apow + ((jj + 1) * 64 + 4 * pq + 2) * 2);
        const f32x4 c01 = *(const LAS f32x4*)(Cc + (h * 64 + 4 * pq) * 2), c23 = *(const LAS f32x4*)(Cc + (h * 64 + 4 * pq + 2) * 2);
        u32x4 w;
        w.x = pk2(c01.x * a01.x - c01.y * a01.y, -(c01.x * a01.y + c01.y * a01.x)); w.y = pk2(c01.z * a01.z - c01.w * a01.w, -(c01.z * a01.w + c01.w * a01.z));
        w.z = pk2(c23.x * a23.x - c23.y * a23.y, -(c23.x * a23.y + c23.y * a23.x)); w.w = pk2(c23.z * a23.z - c23.w * a23.w, -(c23.z * a23.w + c23.w * a23.z));
        *(u32x4*)(B2 + (size_t)(g * 512 + l * 16 + h) * 768 + 512 + dir * 128 + 8 * pq) = w; }
    if (jq == 3 && tid < 64) { adec[(gd * 64 + tid) * 2] = apow[(8 * 64 + tid) * 2]; adec[(gd * 64 + tid) * 2 + 1] = apow[(8 * 64 + tid) * 2 + 1]; }
    __syncthreads();
}
__device__ __forceinline__ void toeplitz_items(const float* Ktab, const float* ssm_d, bf16_t* B2, int gt, int NGT) {
#pragma unroll 4
    for (int item = gt; item < 16384 * 64; item += NGT) {
        const int n = item >> 6, kc = (item & 63) * 8, lp = kc >> 4, hp0 = kc & 15, g = n >> 9, l = (n >> 4) & 31, h = n & 15;
        const int jf = l - lp > 0 ? l - lp : 0, jb = lp - l > 0 ? lp - l : 0;
        const float mf = lp <= l ? 1.f : 0.f, mb = lp >= l ? 1.f : 0.f;
        const f32x4* kf = (const f32x4*)(Ktab + ((size_t)((g * 2 + 0) * 32 + jf) * 16 + h) * 16 + hp0);
        const f32x4* kb = (const f32x4*)(Ktab + ((size_t)((g * 2 + 1) * 32 + jb) * 16 + h) * 16 + hp0);
        const f32x4 f0 = kf[0], f1 = kf[1], b0 = kb[0], b1 = kb[1];
        const float d = (lp == l && (h >> 3) == (hp0 >> 3)) ? ssm_d[g * 16 + h] : 0.f;
        f32x4 v0 = f0 * mf + b0 * mb, v1 = f1 * mf + b1 * mb;
        const int i = h & 7;
        v0.x += i == 0 ? d : 0.f; v0.y += i == 1 ? d : 0.f; v0.z += i == 2 ? d : 0.f; v0.w += i == 3 ? d : 0.f;
        v1.x += i == 4 ? d : 0.f; v1.y += i == 5 ? d : 0.f; v1.z += i == 6 ? d : 0.f; v1.w += i == 7 ? d : 0.f;
        u32x4 w; w.x = pk2(v0.x, v0.y); w.y = pk2(v0.z, v0.w); w.z = pk2(v1.x, v1.y); w.w = pk2(v1.z, v1.w);
        *(u32x4*)(B2 + (size_t)n * 768 + kc) = w;
    }
}
__device__ __forceinline__ void conv_tile(const bf16_t* GC, const float* cw, const float* cb, const float* lng, const float* lnb, const float* og, bf16_t* CAT, LAS float* sc, int tile, int tid, int lane, int wave) {
    const int t0 = tile * 32, half = tid >> 8, cp = tid & 255, c = 2 * cp;
    const int tb = t0 + half * 16, lseq = tb & (SEQ - 1);
    unsigned in[46];
#pragma unroll
    for (int i = 0; i < 46; ++i) { const int tt = lseq - 15 + i; in[i] = (tt >= 0 && tt < SEQ) ? *(const unsigned*)(GC + (size_t)(tb - 15 + i) * DC + c) : 0u; }
    float a0[16], a1[16];
    { const f32x2 b = *(const f32x2*)(cb + c);
#pragma unroll
      for (int o = 0; o < 16; ++o) { a0[o] = b.x; a1[o] = b.y; } }
#pragma unroll
    for (int k = 0; k < 31; ++k) { const f32x2 w = *(const f32x2*)(cw + k * DC + c);
#pragma unroll
        for (int o = 0; o < 16; ++o) { a0[o] += w.x * bf_lo(in[o + k]); a1[o] += w.y * bf_hi(in[o + k]); } }
#pragma unroll
    for (int o = 0; o < 16; ++o) *(LAS f32x2*)(sc + (half * 16 + o) * 512 + c) = (f32x2){a0[o], a1[o]};
    __syncthreads();
    const int c8 = 8 * lane;
    const f32x4 g0 = *(const f32x4*)(lng + c8), g1 = *(const f32x4*)(lng + c8 + 4), b0 = *(const f32x4*)(lnb + c8), b1 = *(const f32x4*)(lnb + c8 + 4);
    const f32x4 o0 = *(const f32x4*)(og + c8), o1 = *(const f32x4*)(og + c8 + 4);
#pragma unroll
    for (int q = 0; q < 4; ++q) { const int tok = 4 * wave + q;
        f32x4 x0 = *(const LAS f32x4*)(sc + tok * 512 + c8), x1 = *(const LAS f32x4*)(sc + tok * 512 + c8 + 4);
        const float mean = wave_sum((x0.x + x0.y) + (x0.z + x0.w) + (x1.x + x1.y) + (x1.z + x1.w)) * (1.0f / 512.0f);
        x0 = x0 - mean; x1 = x1 - mean;
        const float var = wave_sum((x0.x * x0.x + x0.y * x0.y) + (x0.z * x0.z + x0.w * x0.w) + (x1.x * x1.x + x1.y * x1.y) + (x1.z * x1.z + x1.w * x1.w)) * (1.0f / 512.0f);
        const float rstd = 1.0f / sqrtf(var + EPS);
        x0 = x0 * rstd * g0 + b0; x1 = x1 * rstd * g1 + b1;
        float y[8] = {silu_f(x0.x), silu_f(x0.y), silu_f(x0.z), silu_f(x0.w), silu_f(x1.x), silu_f(x1.y), silu_f(x1.z), silu_f(x1.w)};
        float ss = 0.f;
#pragma unroll
        for (int j = 0; j < 8; ++j) ss += y[j] * y[j];
        ss = sum8_dpp(ss);
        const float r = 1.0f / sqrtf(ss * (1.0f / 64.0f) + EPS);
        u32x4 w; w.x = pk2(y[0] * r * o0.x, y[1] * r * o0.y); w.y = pk2(y[2] * r * o0.z, y[3] * r * o0.w); w.z = pk2(y[4] * r * o1.x, y[5] * r * o1.y); w.w = pk2(y[6] * r * o1.z, y[7] * r * o1.w);
        *(u32x4*)(CAT + (size_t)(t0 + tok) * D + c8) = w; }
    __syncthreads();
}
__device__ __forceinline__ void scan_item(const float* X, const float* adec, bf16_t* A2, int item, int lane) {
    const int g = item >> 3, b = (item >> 1) & 3, dir = item & 1, p = lane;
    const f32x2 ad = *(const f32x2*)(adec + ((g * 2 + dir) * 64 + p) * 2);
    const int row0 = g * 512 + b * 128;
    const float* xp = X + (size_t)row0 * 256 + dir * 128 + 2 * p;
    bf16_t* sp = A2 + (size_t)row0 * 768 + 512 + dir * 128 + 2 * p;
    float sr = 0.f, si = 0.f;
    f32x2 xa[16], xb[16]; unsigned ob[16];
#define SCAN_LOAD(buf, cb) do { _Pragma("unroll") for (int i = 0; i < 16; ++i) { const int c = dir == 0 ? (cb) + i : 127 - ((cb) + i); buf[i] = *(const f32x2*)(xp + (size_t)c * 256); } } while (0)
#define SCAN_STEP(buf) do { _Pragma("unroll") for (int i = 0; i < 16; ++i) { ob[i] = pk2(sr, si); \
        const float nr = ad.x * sr - ad.y * si + buf[i].x, ni = ad.x * si + ad.y * sr + buf[i].y; sr = nr; si = ni; } } while (0)
#define SCAN_STORE(cb) do { _Pragma("unroll") for (int i = 0; i < 16; ++i) { const int c = dir == 0 ? (cb) + i : 127 - ((cb) + i); *(unsigned*)(sp + (size_t)c * 768) = ob[i]; } } while (0)
    SCAN_LOAD(xa, 0); SCAN_LOAD(xb, 16);
#pragma unroll 1
    for (int cb = 0; cb < 128; cb += 32) {
        SCAN_STEP(xa); if (cb + 32 < 128) SCAN_LOAD(xa, cb + 32); SCAN_STORE(cb);
        SCAN_STEP(xb); if (cb + 48 < 128) SCAN_LOAD(xb, cb + 48); SCAN_STORE(cb + 16);
    }
#undef SCAN_STORE
#undef SCAN_LOAD
#undef SCAN_STEP
}

struct Args { const float* in[40]; float* out; unsigned char* ws; int lo, hi; };

__global__ void __launch_bounds__(512, 2) hybrid_fwd(Args a) {
    extern __shared__ __attribute__((aligned(16))) unsigned char lds_raw[];
    LAS unsigned char* lds = (LAS unsigned char*)lds_raw;
    LAS float* ldsf = (LAS float*)lds_raw;
    cg::grid_group grid = cg::this_grid();
    const int tid = threadIdx.x, lane = tid & 63, wave = __builtin_amdgcn_readfirstlane(tid >> 6);
    const int G = gridDim.x, bid = blockIdx.x;
    const int gw = bid * 8 + wave, NGW = G * 8;
    const int lo = a.lo, hi = a.hi;
    unsigned char* ws = a.ws;
    bf16_t* Wgu1 = (bf16_t*)(ws + WS_WGU1); bf16_t* Wd1 = (bf16_t*)(ws + WS_WD1); bf16_t* Wgu2 = (bf16_t*)(ws + WS_WGU2); bf16_t* Wd2 = (bf16_t*)(ws + WS_WD2);
    bf16_t* Win = (bf16_t*)(ws + WS_WIN); bf16_t* Wglu = (bf16_t*)(ws + WS_WGLU); bf16_t* Wout = (bf16_t*)(ws + WS_WOUT);
    bf16_t* B2 = (bf16_t*)(ws + WS_B2); bf16_t* Wst = (bf16_t*)(ws + WS_WST); float* Ktab = (float*)(ws + WS_KTAB); float* adec = (float*)(ws + WS_ADEC);
    bf16_t* U = (bf16_t*)(ws + WS_U); bf16_t* F = (bf16_t*)(ws + WS_F); bf16_t* ACT = (bf16_t*)(ws + WS_ACT);
    bf16_t* GC = (bf16_t*)(ws + WS_GC); bf16_t* A2 = (bf16_t*)(ws + WS_A2); float* X = (float*)(ws + WS_X); bf16_t* YG = (bf16_t*)(ws + WS_YG);
    bf16_t* CAT = U;
    bf16_t* HB = (bf16_t*)(ws + WS_HB);
#define IN(k) (lo <= (k) && (k) < hi)
    volatile LAS unsigned* bst = (volatile LAS unsigned*)(lds + LDS_CTL);
    LAS TrDesc* desc = (LAS TrDesc*)(lds + LDS_CTL + 64);
    constexpr int I_G = (D / 64) * (DFF / 32), I_D = (DFF / 64) * (D / 32), I_IN = (D / 64) * (DIN / 32), I_GLU = (DS / 64) * (DS / 32), I_O = (D / 64) * (D / 32);
    constexpr int C0 = I_G, C1 = C0 + I_G, C2 = C1 + I_D, C3 = C2 + I_IN, C4 = C3 + I_G, C5 = C4 + I_G, C6 = C5 + I_D, C7 = C6 + I_GLU, C8 = C7 + I_O;
    if (tid == 0) { bst[0] = 0u; bst[1] = 0u;
        set_desc(desc + 0, a.in[2], (bf16_t*)(ws + WS_WGU1), D, DFF, 1, C0);  set_desc(desc + 1, a.in[3], (bf16_t*)(ws + WS_WGU1), D, DFF, 2, C1);  set_desc(desc + 2, a.in[4], (bf16_t*)(ws + WS_WD1), DFF, D, 0, C2);
        set_desc(desc + 3, a.in[7], (bf16_t*)(ws + WS_WIN), D, DIN, 3, C3, a.in[6]);
        set_desc(desc + 4, a.in[36], (bf16_t*)(ws + WS_WGU2), D, DFF, 1, C4, a.in[35]); set_desc(desc + 5, a.in[37], (bf16_t*)(ws + WS_WGU2), D, DFF, 2, C5, a.in[35]);
        set_desc(desc + 6, a.in[38], (bf16_t*)(ws + WS_WD2), DFF, D, 0, C6); set_desc(desc + 7, a.in[29], (bf16_t*)(ws + WS_WGLU), DS, DS, 4, C7); set_desc(desc + 8, a.in[32], (bf16_t*)(ws + WS_WOUT), D, D, 0, C8); }
    __syncthreads();
    XcdBarrier xbar; xbar.bar = (unsigned*)(ws + WS_BAR); xbar.x = 0; xbar.st = bst;
    if (hi - lo > 1) xbar = xcd_barrier_post((unsigned*)(ws + WS_BAR), bst);
#ifndef CG_SEAM
#define CG_SEAM 0
#endif
    if (hi > NPH) grid.sync();
#define SEAM(k) do { if (IN(k) && IN((k) + 1)) xcd_barrier(xbar); } while (0)

#define TAIL_VARS const bool tailwg = (G == 256) ? (bid >= 128) : true; const int tgw = (G == 256) ? (bid - 128) * 8 + wave : gw, TNGW = (G == 256) ? 128 * 8 : NGW; const int tb = (G == 256) ? bid - 128 : bid, TG = (G == 256) ? 128 : G; LAS float* scr = ldsf + wave * (64 * 33)
    if (IN(0)) {
#pragma unroll 1
        for (int pass = 0; pass < 3; ++pass) {
            if (pass == 1) {
                tr_range(desc, 0, 0, C1, gw, NGW, ldsf + wave * (64 * 33), lane);
                norm_rows(a.in[0], a.in[1], U, gw, NGW, lane);
                __syncthreads();
            } else if ((pass == 0) == ((bid & 1) != 0)) {
                for (int it = bid; it < 256; it += G) {
                    const int gd = it >> 2, jq = it & 3, g = gd >> 1, dir = gd & 1;
                    const SsmIn si{dir ? a.in[21] : a.in[14], dir ? a.in[22] : a.in[15], dir ? a.in[23] : a.in[16], dir ? a.in[24] : a.in[17], dir ? a.in[25] : a.in[18], dir ? a.in[26] : a.in[19], dir ? a.in[27] : a.in[20]};
                    ssm_tables_item(si, g, dir, jq, Ktab, Wst, B2, adec, ldsf, tid);
                }
            }
        }
    }
    SEAM(0);
    if (IN(1)) {
        pg8::Gemm g{U, Wgu1, D, D, D}; pg8::Sched S; S.init(0, T, 2 * DFF, G, bid);
        pg8::EpiSwiGLU E{ACT, DFF, nullptr, nullptr, -1};
        pg8::gemm_phase(lds, g, S, E);
        TAIL_VARS;
        if (tailwg) tr_range(desc, 2, C1, C3, tgw, TNGW, scr, lane);
    }
    SEAM(1);
    float* SS = (float*)(ws + WS_SS);
    if (IN(2)) {
        pg8::Gemm g{ACT, Wd1, DFF, DFF, DFF}; pg8::Sched S; S.init(0, T, D, G, bid);
        pg8::EpiNormRes E{a.in[0], nullptr, 0.5f, a.in[5], nullptr, SS, SS + T, HB, nullptr, &xbar};
        pg8::gemm_phase(lds, g, S, E);
    }
    SEAM(2);
    if (IN(4)) {
        pg8::Gemm g{HB, Win, D, D, D}; pg8::Sched S; S.init(0, T, DIN, G, bid);
        LAS float* rtab = (LAS float*)(lds + pg8::STAGE_BYTES);
        pg8::Unit u0; const int pm0 = S.next(0, u0) ? u0.pm : -1;
        if (pm0 >= 0 && tid < 256) rtab[tid] = __builtin_amdgcn_rsqf(SS[T + pm0 * 256 + tid] * (1.0f / D) + EPS);
        __syncthreads();
        pg8::EpiWin E{GC, A2, a.in[8], SS + T, rtab, pm0};
        pg8::gemm_phase(lds, g, S, E);
        TAIL_VARS;
        if (tailwg) {
            tr_range(desc, 4, C3, C5, tgw, TNGW, scr, lane);
            toeplitz_items(Ktab, a.in[28], B2, tb * 512 + tid, TG * 512);
        }
    }
    SEAM(4);
    if (IN(5)) {
        if (bid < 64) {
            pg8::Gemm g{A2, Wst, 768, 512, 512}; pg8::Sched S; S.init(1, 0, 0, 64, bid);
            pg8::EpiXScan E{lds, adec, A2};
            pg8::gemm_phase(lds, g, S, E);
        } else {
            for (int tile = bid - 64; tile < 384; tile += G - 64) conv_tile(GC, a.in[9], a.in[10], a.in[11], a.in[12], a.in[13], CAT, ldsf, tile, tid, lane, wave);
        }
    }
    SEAM(6);
    if (IN(7)) {
        pg8::Gemm g{A2, B2, 768, 768, 768}; pg8::Sched S; S.init(2, 0, 0, G, bid);
        pg8::EpiS2 E{YG};
        pg8::gemm_phase(lds, g, S, E);
        TAIL_VARS;
        if (G == 256 && bid >= 128) conv_tile(GC, a.in[9], a.in[10], a.in[11], a.in[12], a.in[13], CAT, ldsf, 384 + bid - 128, tid, lane, wave);
        if (tailwg) tr_range(desc, 6, C5, C8, tgw, TNGW, scr, lane);
    }
    SEAM(7);
    if (IN(8)) {
        pg8::Gemm g{YG, Wglu, DS, DS, DS}; pg8::Sched S; S.init(0, T, DS, G, bid);
        pg8::EpiGlu E{YG, CAT, a.in[30], a.in[31]};
        pg8::gemm_phase(lds, g, S, E);
    }
    SEAM(8);
    if (IN(9)) {
        pg8::Gemm g{CAT, Wout, D, D, D}; pg8::Sched S; S.init(0, T, D, G, bid);
        pg8::EpiNormRes E{nullptr, HB, 1.0f, a.in[34], a.in[33], SS + 2 * T, SS + 3 * T, HB, nullptr, &xbar};
        pg8::gemm_phase(lds, g, S, E);
    }
    SEAM(9);
    if (IN(11)) {
        pg8::Gemm g{HB, Wgu2, D, D, D}; pg8::Sched S; S.init(0, T, 2 * DFF, G, bid);
        LAS float* rtab = (LAS float*)(lds + pg8::STAGE_BYTES);
        pg8::Unit u0; const int pm0 = S.next(0, u0) ? u0.pm : -1;
        if (pm0 >= 0 && tid < 256) rtab[tid] = __builtin_amdgcn_rsqf(SS[3 * T + pm0 * 256 + tid] * (1.0f / D) + EPS);
        __syncthreads();
        pg8::EpiSwiGLU E{ACT, DFF, SS + 3 * T, rtab, pm0};
        pg8::gemm_phase(lds, g, S, E);
    }
    SEAM(11);
    if (IN(12)) {
        pg8::Gemm g{ACT, Wd2, DFF, DFF, DFF}; pg8::Sched S; S.init(0, T, D, G, bid);
        pg8::EpiNormRes E{nullptr, HB, 0.5f, a.in[39], nullptr, SS + 4 * T, nullptr, nullptr, a.out, &xbar};
        pg8::gemm_phase(lds, g, S, E);
    }
#undef IN
#undef SEAM
}

extern "C" void kernel_launch(void* const* d_in, const int* in_sizes, int n_in, void* d_out, int out_size, void* d_ws, size_t ws_size, hipStream_t stream) {
    constexpr int LDS_BYTES = LDS_CTL + 512;
    static int grid = 0;
    if (grid == 0) {
        int dev = 0, cus = 0, per_cu = 0;
        if (n_in != 40 || ws_size < WS_END) { fprintf(stderr, "kernel_launch: unexpected n_in %d / ws_size %zu (need %zu)\n", n_in, ws_size, (size_t)WS_END); grid = -1; return; }
        hipGetDevice(&dev);
        hipDeviceGetAttribute(&cus, hipDeviceAttributeMultiprocessorCount, dev);
        if (hipFuncSetAttribute((const void*)hybrid_fwd, hipFuncAttributeMaxDynamicSharedMemorySize, LDS_BYTES) != hipSuccess) { fprintf(stderr, "kernel_launch: hipFuncSetAttribute failed\n"); grid = -1; return; }
        if (hipOccupancyMaxActiveBlocksPerMultiprocessor(&per_cu, (const void*)hybrid_fwd, 512, LDS_BYTES) != hipSuccess || per_cu < 1) { fprintf(stderr, "kernel_launch: occupancy query failed (%d)\n", per_cu); (void)hipGetLastError(); per_cu = 1; }
        if (cus != 256) { fprintf(stderr, "kernel_launch: built for a 256-CU device (one 256x256 unit per workgroup in the fused-norm GEMM phases); got %d CUs\n", cus); grid = -1; return; }
        grid = cus * 1;
        if (grid <= 0) grid = 256;
    }
    if (grid < 0) return;
    if (hipMemsetAsync((unsigned char*)d_ws + WS_BAR, 0, ZERO_BYTES, stream) != hipSuccess) { fprintf(stderr, "kernel_launch: hipMemsetAsync failed\n"); return; }
    Args a{};
    for (int i = 0; i < 40; ++i) a.in[i] = (const float*)d_in[i];
    a.out = (float*)d_out; a.ws = (unsigned char*)d_ws;
    a.lo = 0; a.hi = NPH;
    void* args[] = {&a};
    hipError_t e = hipLaunchCooperativeKernel((const void*)hybrid_fwd, dim3(grid), dim3(512), args, LDS_BYTES, stream);
    if (e != hipSuccess) fprintf(stderr, "kernel_launch: cooperative launch failed: %s (grid %d)\n", hipGetErrorString(e), grid);
}
```

```cpp
#include <hip/hip_runtime.h>
#include <hip/hip_cooperative_groups.h>
#include <cstdio>
namespace cg = cooperative_groups;


#define LAS __attribute__((address_space(3)))
typedef unsigned short bf16_t;
typedef short bf16x8 __attribute__((ext_vector_type(8)));
typedef float f32x4 __attribute__((ext_vector_type(4)));
typedef float f32x2 __attribute__((ext_vector_type(2)));
typedef unsigned u32x4 __attribute__((ext_vector_type(4)));
typedef unsigned u32x2 __attribute__((ext_vector_type(2)));

constexpr int T = 16384, D = 1024, DFF = 2816, DIN = 1536, DC = 512, DS = 512, SEQ = 4096;
constexpr int NPH = 14;
constexpr int LDS_CTL = 136 * 1024;
constexpr float EPS = 1e-6f;

constexpr size_t SZ_WGU = (size_t)2 * DFF * D * 2, SZ_WD = (size_t)D * DFF * 2;
constexpr size_t WS_WGU1 = 0, WS_WD1 = WS_WGU1 + SZ_WGU, WS_WGU2 = WS_WGU1, WS_WD2 = WS_WD1;
constexpr size_t WS_HB = WS_WD1 + SZ_WD;
constexpr size_t WS_WIN = WS_HB + (size_t)T * D * 2, WS_WGLU = WS_WIN + (size_t)DIN * D * 2, WS_WOUT = WS_WGLU + (size_t)DS * DS * 2;
constexpr size_t WS_B2 = WS_WOUT + (size_t)D * D * 2;
constexpr size_t WS_WST = WS_B2 + (size_t)16384 * 768 * 2;
constexpr size_t WS_KTAB = WS_WST + (size_t)8192 * 512 * 2;
constexpr size_t WS_ADEC = WS_KTAB + (size_t)64 * 32 * 256 * 4;
constexpr size_t WS_U = WS_ADEC + (size_t)64 * 64 * 2 * 4;
constexpr size_t WS_F = WS_U + (size_t)T * D * 2;
constexpr size_t WS_ACT = WS_F + (size_t)T * D * 2;
constexpr size_t WS_GC = WS_ACT;
constexpr size_t WS_A2 = WS_GC + (size_t)T * DC * 2;
constexpr size_t WS_X = WS_A2 + (size_t)16384 * 768 * 2;
constexpr size_t WS_YG = WS_X + (size_t)16384 * 256 * 4;
constexpr size_t WS_BAR = WS_ACT + (size_t)T * DFF * 2;
constexpr size_t WS_SS = WS_BAR + 16384;
constexpr size_t WS_END = WS_SS + (size_t)5 * T * 4;
constexpr size_t ZERO_BYTES = WS_END - WS_BAR;
static_assert(WS_YG + (size_t)T * DS * 2 <= WS_BAR, "mixer aliases fit");
static_assert(WS_END <= (size_t)256 * 1024 * 1024, "workspace");

__device__ __forceinline__ unsigned pk2(float lo, float hi) { unsigned r; asm volatile("v_cvt_pk_bf16_f32 %0, %1, %2" : "=v"(r) : "v"(lo), "v"(hi)); return r; }
__device__ __forceinline__ float bf_lo(unsigned v) { return __uint_as_float(v << 16); }
__device__ __forceinline__ float bf_hi(unsigned v) { return __uint_as_float(v & 0xffff0000u); }
__device__ __forceinline__ float sigmoid_f(float x) { return __builtin_amdgcn_rcpf(1.0f + __builtin_amdgcn_exp2f(-1.4426950408889634f * x)); }
__device__ __forceinline__ float silu_f(float x) { return x * sigmoid_f(x); }
__device__ __forceinline__ float gelu_tanh_f(float x) { return x * sigmoid_f(1.5957691216057308f * (x + 0.044715f * x * x * x)); }
template <int CTRL> __device__ __forceinline__ float dpp_f(float v) { return __builtin_bit_cast(float, __builtin_amdgcn_update_dpp(0, __builtin_bit_cast(int, v), CTRL, 0xF, 0xF, true)); }
__device__ __forceinline__ float sum8_dpp(float v) {
    v += dpp_f<0xB1>(v);
    v += dpp_f<0x4E>(v);
    v += dpp_f<0x141>(v);
    return v;
}
__device__ __forceinline__ float wave_sum(float v) {
    v = sum8_dpp(v);
    v += dpp_f<0x140>(v);
    const int iv = __builtin_bit_cast(int, v);
    const float r0 = __builtin_bit_cast(float, __builtin_amdgcn_readlane(iv, 0)), r1 = __builtin_bit_cast(float, __builtin_amdgcn_readlane(iv, 16));
    const float r2 = __builtin_bit_cast(float, __builtin_amdgcn_readlane(iv, 32)), r3 = __builtin_bit_cast(float, __builtin_amdgcn_readlane(iv, 48));
    return (r0 + r1) + (r2 + r3);
}

#define XB_TMO      128
#define XB_XCNT(j)  (256  + 64 * (j))
#define XB_XSUB(j)  (1280 + 64 * (j))
#define XB_XGEN(j)  (2304 + 64 * (j))
#define XB_TOP      3328
#define XB_TOPGEN   3392
#define XCD_BAR_WORDS 3456
#define XB_SPIN_CAP (1u << 18)
__device__ __forceinline__ unsigned xb_ld(unsigned* p)              { return __hip_atomic_load(p, __ATOMIC_RELAXED, __HIP_MEMORY_SCOPE_AGENT); }
__device__ __forceinline__ unsigned xb_add(unsigned* p, unsigned v) { return __hip_atomic_fetch_add(p, v, __ATOMIC_RELAXED, __HIP_MEMORY_SCOPE_AGENT); }
__device__ __forceinline__ unsigned xb_xcc_id() { return (unsigned)__builtin_amdgcn_s_getreg((3 << 11) | 20) & 0xFu; }
#define XB_SPIN(cond, bar) do { unsigned _sp = 0; while (cond) { __builtin_amdgcn_s_sleep(1); \
    if ((++_sp & 255u) == 0u) { if (xb_ld(&(bar)[XB_TMO])) break; if (_sp > XB_SPIN_CAP) { atomicAdd(&(bar)[XB_TMO], 1u); break; } } } } while (0)
struct XcdBarrier { unsigned* bar; unsigned x; volatile LAS unsigned* st; };
__device__ __forceinline__ XcdBarrier xcd_barrier_post(unsigned* bar, volatile LAS unsigned* st) {
    XcdBarrier b; b.bar = bar; b.x = xb_xcc_id(); b.st = st;
    if (threadIdx.x == 0) (void)xb_add(&bar[XB_XCNT(b.x)], 1u);
    return b;
}
__device__ __forceinline__ void xcd_barrier_complete(unsigned* bar, unsigned x, unsigned& nloc, unsigned& nx) {
    const unsigned G = gridDim.x * gridDim.y * gridDim.z;
    unsigned sum, cnt, mine, sp = 0u;
    for (;;) {
        sum = 0u; cnt = 0u; mine = 0u;
#pragma unroll
        for (unsigned j = 0; j < 16; ++j) { const unsigned c = xb_ld(&bar[XB_XCNT(j)]); sum += c; cnt += (c > 0u) ? 1u : 0u; mine = (j == x) ? c : mine; }
        if (sum == G) break;
        __builtin_amdgcn_s_sleep(1);
        if ((++sp & 255u) == 0u) { if (xb_ld(&bar[XB_TMO])) break; if (sp > XB_SPIN_CAP) { atomicAdd(&bar[XB_TMO], 1u); break; } }
    }
    nloc = mine > 0u ? mine : 1u; nx = cnt > 0u ? cnt : 1u;
}
__device__ __forceinline__ void xcd_barrier(const XcdBarrier& b) {
    asm volatile("s_waitcnt vmcnt(0)" ::: "memory");
    __syncthreads();
    if (threadIdx.x == 0) {
        unsigned* bar = b.bar;
        __builtin_amdgcn_s_waitcnt(0);
        unsigned nloc = b.st[0], nx = b.st[1];
        if (nloc == 0u) { xcd_barrier_complete(bar, b.x, nloc, nx); b.st[0] = nloc; b.st[1] = nx; }
        const unsigned old = xb_add(&bar[XB_XSUB(b.x)], 1u);
        const unsigned gen = old / nloc;
        if (old + 1u == (gen + 1u) * nloc) {
            __builtin_amdgcn_fence(__ATOMIC_RELEASE, "agent");
            asm volatile("s_waitcnt vmcnt(0)" ::: "memory");
            const unsigned og = xb_add(&bar[XB_TOP], 1u);
            const unsigned tg = og / nx;
            if (og + 1u == (tg + 1u) * nx) xb_add(&bar[XB_TOPGEN], 1u);
            else XB_SPIN(xb_ld(&bar[XB_TOPGEN]) == tg, bar);
            __builtin_amdgcn_fence(__ATOMIC_ACQUIRE, "agent");
            xb_add(&bar[XB_XGEN(b.x)], 1u);
            asm volatile("s_waitcnt vmcnt(0)" ::: "memory");
        } else {
            XB_SPIN(xb_ld(&bar[XB_XGEN(b.x)]) == gen, bar);
            __builtin_amdgcn_fence(__ATOMIC_ACQUIRE, "agent");
            asm volatile("s_waitcnt vmcnt(0)" ::: "memory");
        }
    }
    __syncthreads();
}

namespace pg8 {
constexpr int BM = 256, BK = 64, HALF = 128, HTB = HALF * BK * 2, STAGE_BYTES = 8 * HTB, NXCD = 8, WGM = 8;
__host__ __device__ __forceinline__ int lds_byte(int r, int c) { const int st = (r >> 4) * 2 + (c >> 5), rr = r & 15, cc = c & 31, ob = rr * 64 + cc * 2; return st * 1024 + (ob ^ (((ob >> 9) & 1) << 5)); }
__host__ __device__ __forceinline__ void stage_rc(int b, int& R, int& C) { const int st = b / 1024, sb = b % 1024, swz = sb ^ (((sb >> 9) & 1) << 5); R = (st >> 1) * 16 + swz / 64; C = (st & 1) * 32 + (swz % 64) / 2; }
__host__ __device__ __forceinline__ int perm32(int rho) { const int n = rho >> 4, i = rho & 15; return 8 * (i >> 2) + 4 * n + (i & 3); }

struct Unit { int pm, pn, pb; };
struct Gemm { const bf16_t* A; const bf16_t* Bt; int lda, ldb, K; };

struct Sched {
    int mode, nM, nN, nwg, G, c;
    __device__ __forceinline__ void init(int mode_, int M, int N, int G_, int c_) { mode = mode_; nM = M / BM; nN = N / BM; nwg = nM * nN; G = G_; c = c_; }
    __device__ __forceinline__ bool next(int i, Unit& u) const {
        const long L = (long)i * G + c;
        if (mode == 1) { if (L >= 64) return false; u.pm = (int)L; u.pn = 0; u.pb = (int)L >> 1; return true; }
        if (mode == 2) { if (L >= 128) return false; u.pm = (int)L >> 1; u.pn = (int)L & 1; u.pb = (u.pm >> 1) * 2 + u.pn; return true; }
        if (L >= nwg) return false;
        int wgid = (int)L; { const int q = nwg / NXCD, r = nwg % NXCD, xcd = wgid % NXCD, off = wgid / NXCD; wgid = (xcd < r ? xcd * (q + 1) : r * (q + 1) + (xcd - r) * q) + off; }
        const int nig = WGM * nN, gid = wgid / nig, fm = gid * WGM, gsz = (nM - fm) < WGM ? (nM - fm) : WGM;
        u.pm = fm + ((wgid % nig) % gsz); u.pn = (wgid % nig) / gsz; u.pb = u.pn; return true;
    }
};

typedef f32x4 Acc[2][2][4][2];

template <class Epi>
__device__ __forceinline__ void gemm_phase(LAS unsigned char* lds, const Gemm g, const Sched& S, const Epi& E) {
    const int tid = threadIdx.x, wid = __builtin_amdgcn_readfirstlane(tid >> 6), lane = tid & 63, wr = wid >> 2, wc = wid & 3, fr = lane & 15, fq = lane >> 4;
    const int K = g.K, nt = K / BK;
    unsigned voffA[2], voffB[2];
#pragma unroll
    for (int i = 0; i < 2; ++i) { int R, C; stage_rc(tid * 16 + i * 8192, R, C); const int Rb = Epi::PERM ? ((R & ~31) + perm32(R & 31)) : R;
        voffA[i] = (unsigned)(R * g.lda + C) * 2u; voffB[i] = (unsigned)(Rb * g.ldb + C) * 2u; }
    const size_t kstep = (size_t)(BK * 2);
    const size_t hstepA = (size_t)HALF * g.lda * 2, hstepB = (size_t)HALF * g.ldb * 2;
    const size_t tstepA = 2 * hstepA, tstepB = 2 * hstepB;
    const unsigned ldsw = (unsigned)wid * 1024u;
    const int aoff = lds_byte(wr * 64 + fr, fq * 8), boff = lds_byte(wc * 32 + fr, fq * 8);
#define PG8_SA(b, h) (((b) * 2 + (h)) * HTB)
#define PG8_SB(b, h) ((4 + (b) * 2 + (h)) * HTB)
#define PG8_STAGE(bufoff, gbase, voff) do { _Pragma("unroll") for (int _i = 0; _i < 2; ++_i) \
        __builtin_amdgcn_global_load_lds((const unsigned*)((const char*)(gbase) + (voff)[_i]), (LAS unsigned*)(lds + (bufoff) + ldsw + _i * 8192), 16, 0, 0); } while (0)
#define PG8_LDA(dst, b, h) do { _Pragma("unroll") for (int m = 0; m < 4; ++m) _Pragma("unroll") for (int k = 0; k < 2; ++k) dst[m][k] = *(const LAS bf16x8*)(lds + PG8_SA(b, h) + aoff + m * 2048 + k * 1024); } while (0)
#define PG8_LDB(dst, b, h) do { _Pragma("unroll") for (int n = 0; n < 2; ++n) _Pragma("unroll") for (int k = 0; k < 2; ++k) dst[n][k] = *(const LAS bf16x8*)(lds + PG8_SB(b, h) + boff + n * 2048 + k * 1024); } while (0)
#define PG8_MMA(ai, bj, At, Bt) do { __builtin_amdgcn_s_setprio(1); _Pragma("unroll") for (int m = 0; m < 4; ++m) _Pragma("unroll") for (int n = 0; n < 2; ++n) _Pragma("unroll") for (int k = 0; k < 2; ++k) \
        acc[ai][bj][m][n] = __builtin_amdgcn_mfma_f32_16x16x32_bf16(Bt[n][k], At[m][k], acc[ai][bj][m][n], 0, 0, 0); __builtin_amdgcn_s_setprio(0); } while (0)
#define PG8_WAIT_V(n) asm volatile("s_waitcnt vmcnt(" #n ")" ::: "memory")
#define PG8_WAIT_L(n) asm volatile("s_waitcnt lgkmcnt(" #n ")" ::: "memory")
#define PG8_BAR __builtin_amdgcn_s_barrier()
#define PG8_SCHED __builtin_amdgcn_sched_barrier(0)
    Unit cur, nxt; int ui = 0;
    if (!S.next(0, cur)) return;
    Acc acc;
#pragma unroll
    for (int a = 0; a < 2; ++a)
#pragma unroll
        for (int b = 0; b < 2; ++b)
#pragma unroll
            for (int m = 0; m < 4; ++m)
#pragma unroll
                for (int n = 0; n < 2; ++n) acc[a][b][m][n] = (f32x4){0.f, 0.f, 0.f, 0.f};
    bf16x8 At[4][2], B0[2][2], B1[2][2];
    const char* cA = (const char*)g.A + (size_t)cur.pm * tstepA; const char* cB = (const char*)g.Bt + (size_t)cur.pb * tstepB;
    PG8_STAGE(PG8_SB(0, 0), cB, voffB); PG8_STAGE(PG8_SA(0, 0), cA, voffA); PG8_STAGE(PG8_SB(0, 1), cB + hstepB, voffB); PG8_STAGE(PG8_SA(0, 1), cA + hstepA, voffA);
    if (wr == 1) PG8_BAR;
    PG8_WAIT_V(4); PG8_BAR;
    PG8_STAGE(PG8_SB(1, 0), cB + kstep, voffB); PG8_STAGE(PG8_SA(1, 0), cA + kstep, voffA); PG8_STAGE(PG8_SB(1, 1), cB + hstepB + kstep, voffB);
    PG8_WAIT_V(6); PG8_BAR;
    for (;;) {
        const bool has_next = S.next(ui + 1, nxt);
        const char* nA = has_next ? (const char*)g.A + (size_t)nxt.pm * tstepA : cA; const char* nB = has_next ? (const char*)g.Bt + (size_t)nxt.pb * tstepB : cB;
        for (int t = 0; t < nt; t += 2) {
            const bool last = (t == nt - 2);
            const char* a1 = cA + (size_t)(t + 1) * kstep;
            const char* a2 = last ? nA : cA + (size_t)(t + 2) * kstep; const char* b2 = last ? nB : cB + (size_t)(t + 2) * kstep;
            const char* a3 = a2 + kstep; const char* b3 = b2 + kstep;
            PG8_LDB(B0, 0, 0); PG8_SCHED; PG8_LDA(At, 0, 0); PG8_STAGE(PG8_SA(1, 1), a1 + hstepA, voffA);
            PG8_WAIT_L(8); PG8_BAR; PG8_WAIT_L(0); PG8_MMA(0, 0, At, B0); PG8_BAR; PG8_SCHED;
            PG8_LDB(B1, 0, 1); PG8_STAGE(PG8_SB(0, 0), b2, voffB);
            PG8_BAR; PG8_WAIT_L(0); PG8_MMA(0, 1, At, B1); PG8_BAR;
            PG8_LDA(At, 0, 1); PG8_STAGE(PG8_SA(0, 0), a2, voffA);
            PG8_BAR; PG8_WAIT_L(0); PG8_MMA(1, 0, At, B0); PG8_BAR; PG8_SCHED;
            PG8_STAGE(PG8_SB(0, 1), b2 + hstepB, voffB);
            PG8_WAIT_V(6); PG8_BAR; PG8_MMA(1, 1, At, B1); PG8_BAR;
            PG8_LDB(B0, 1, 0); PG8_SCHED; PG8_LDA(At, 1, 0); PG8_STAGE(PG8_SA(0, 1), a2 + hstepA, voffA);
            PG8_WAIT_L(8); PG8_BAR; PG8_WAIT_L(0); PG8_MMA(0, 0, At, B0); PG8_BAR; PG8_SCHED;
            PG8_LDB(B1, 1, 1); PG8_STAGE(PG8_SB(1, 0), b3, voffB);
            PG8_BAR; PG8_WAIT_L(0); PG8_MMA(0, 1, At, B1); PG8_BAR;
            PG8_LDA(At, 1, 1); PG8_STAGE(PG8_SA(1, 0), a3, voffA);
            PG8_BAR; PG8_WAIT_L(0); PG8_MMA(1, 0, At, B0); PG8_BAR; PG8_SCHED;
            PG8_STAGE(PG8_SB(1, 1), b3 + hstepB, voffB);
            PG8_WAIT_V(6); PG8_BAR; PG8_MMA(1, 1, At, B1); PG8_BAR;
        }
        if constexpr (!Epi::AFTER_DRAIN) E(acc, cur, wr, wc, fr, fq);
        if (!has_next) break;
#pragma unroll
        for (int a = 0; a < 2; ++a)
#pragma unroll
            for (int b = 0; b < 2; ++b)
#pragma unroll
                for (int m = 0; m < 4; ++m)
#pragma unroll
                    for (int n = 0; n < 2; ++n) acc[a][b][m][n] = (f32x4){0.f, 0.f, 0.f, 0.f};
        cur = nxt; cA = nA; cB = nB; ++ui;
    }
    PG8_WAIT_V(0);
    if (wr == 0) PG8_BAR;
    PG8_BAR;
    if constexpr (Epi::AFTER_DRAIN) E.fused(acc, cur, wr, wc, fr, fq);
#undef PG8_SA
#undef PG8_SB
#undef PG8_STAGE
#undef PG8_LDA
#undef PG8_LDB
#undef PG8_MMA
#undef PG8_WAIT_V
#undef PG8_WAIT_L
#undef PG8_BAR
#undef PG8_SCHED
}

struct EpiBf16 {
    static constexpr bool PERM = true, AFTER_DRAIN = false;
    bf16_t* O; int ldc; const float* bias;
    __device__ __forceinline__ void operator()(const Acc& acc, const Unit& u, int wr, int wc, int fr, int fq) const {
        const int row0 = u.pm * BM + wr * 64 + fr, col0 = u.pn * BM + wc * 32 + 8 * fq;
        f32x4 bv[2][2];
#pragma unroll
        for (int bj = 0; bj < 2; ++bj)
#pragma unroll
            for (int n = 0; n < 2; ++n) bv[bj][n] = bias ? *(const f32x4*)(bias + col0 + bj * HALF + 4 * n) : (f32x4){0.f, 0.f, 0.f, 0.f};
#pragma unroll
        for (int ai = 0; ai < 2; ++ai)
#pragma unroll
            for (int m = 0; m < 4; ++m) { bf16_t* rowp = O + (size_t)(row0 + ai * HALF + m * 16) * ldc + col0;
#pragma unroll
                for (int bj = 0; bj < 2; ++bj) { const f32x4 v0 = acc[ai][bj][m][0] + bv[bj][0], v1 = acc[ai][bj][m][1] + bv[bj][1];
                    u32x4 w; w.x = pk2(v0[0], v0[1]); w.y = pk2(v0[2], v0[3]); w.z = pk2(v1[0], v1[1]); w.w = pk2(v1[2], v1[3]);
                    *(u32x4*)(rowp + bj * HALF) = w; } }
    }
};
struct EpiF32 {
    static constexpr bool PERM = false, AFTER_DRAIN = false;
    float* C; int ldc;
    __device__ __forceinline__ void operator()(const Acc& acc, const Unit& u, int wr, int wc, int fr, int fq) const {
        const int row0 = u.pm * BM + wr * 64 + fr, col0 = u.pn * BM + wc * 32 + 4 * fq;
#pragma unroll
        for (int ai = 0; ai < 2; ++ai)
#pragma unroll
            for (int m = 0; m < 4; ++m) { float* rowp = C + (size_t)(row0 + ai * HALF + m * 16) * ldc + col0;
#pragma unroll
                for (int bj = 0; bj < 2; ++bj)
#pragma unroll
                    for (int n = 0; n < 2; ++n) *(f32x4*)(rowp + bj * HALF + n * 16) = acc[ai][bj][m][n]; }
    }
};
struct EpiXScan {
    static constexpr bool PERM = false, AFTER_DRAIN = true;
    LAS unsigned char* lds; const float* adec; bf16_t* A2;
    __device__ __forceinline__ void operator()(const Acc&, const Unit&, int, int, int, int) const {}
    __device__ __forceinline__ void fused(Acc& acc, const Unit& u, int wr, int wc, int fr, int fq) const {
        constexpr int PITCH = 520;
#pragma unroll
        for (int ai = 0; ai < 2; ++ai)
#pragma unroll
            for (int m = 0; m < 4; ++m) { const int r = ai * HALF + wr * 64 + m * 16 + fr;
#pragma unroll
                for (int bj = 0; bj < 2; ++bj)
#pragma unroll
                    for (int n = 0; n < 2; ++n) { const int c = bj * HALF + wc * 32 + n * 16 + 4 * fq; const f32x4 v = acc[ai][bj][m][n];
                        u32x2 w; w.x = pk2(v[0], v[1]); w.y = pk2(v[2], v[3]); *(LAS u32x2*)(lds + r * PITCH + c * 2) = w; } }
        __syncthreads();
        const int wave = threadIdx.x >> 6, lane = threadIdx.x & 63;
        if (wave < 4) {
            const int bsel = wave >> 1, dir = wave & 1, g = u.pm >> 1, b = 2 * (u.pm & 1) + bsel;
            const f32x2 ad = *(const f32x2*)(adec + ((g * 2 + dir) * 64 + lane) * 2);
            bf16_t* sp = A2 + (size_t)(g * 512 + b * 128) * 768 + 512 + dir * 128 + 2 * lane;
            const LAS unsigned char* xp = lds + (128 * bsel) * PITCH + (dir * 128 + 2 * lane) * 2;
            float sr = 0.f, si = 0.f;
#pragma unroll 16
            for (int k = 0; k < 128; ++k) { const int c = dir == 0 ? k : 127 - k;
                const unsigned xv = *(const LAS unsigned*)(xp + c * PITCH);
                *(unsigned*)(sp + (size_t)c * 768) = pk2(sr, si);
                const float nr = ad.x * sr - ad.y * si + bf_lo(xv), ni = ad.x * si + ad.y * sr + bf_hi(xv); sr = nr; si = ni; }
        }
    }
};
struct EpiSwiGLU {
    static constexpr bool PERM = true, AFTER_DRAIN = false;
    bf16_t* O; int ldc; const float* rowss; const LAS float* rtab; int pm0;
    __device__ __forceinline__ void operator()(const Acc& acc, const Unit& u, int wr, int wc, int fr, int fq) const {
        const int row0 = u.pm * BM + wr * 64 + fr, col0 = u.pn * HALF + wc * 32 + 8 * fq;
#pragma unroll
        for (int ai = 0; ai < 2; ++ai)
#pragma unroll
            for (int m = 0; m < 4; ++m) { const int row = row0 + ai * HALF + m * 16; bf16_t* rowp = O + (size_t)row * ldc + col0;
                const float r = !rowss ? 1.0f : (u.pm == pm0 ? rtab[row - pm0 * BM] : __builtin_amdgcn_rsqf(rowss[row] * (1.0f / D) + EPS));
                float v[8];
#pragma unroll
                for (int n = 0; n < 2; ++n)
#pragma unroll
                    for (int j = 0; j < 4; ++j) v[4 * n + j] = silu_f(acc[ai][0][m][n][j] * r) * (acc[ai][1][m][n][j] * r);
                u32x4 w; w.x = pk2(v[0], v[1]); w.y = pk2(v[2], v[3]); w.z = pk2(v[4], v[5]); w.w = pk2(v[6], v[7]);
                *(u32x4*)rowp = w; }
    }
};
struct EpiNormRes {
    static constexpr bool PERM = true, AFTER_DRAIN = true;
    const float* res_f32; const bf16_t* res_bf16; float alpha; const float* gpost; const float* bias; float* ss1; float* ss2; bf16_t* hb; float* out; const XcdBarrier* bar;
    __device__ __forceinline__ void operator()(const Acc&, const Unit&, int, int, int, int) const {}
    __device__ __forceinline__ void fused(Acc& acc, const Unit& u, int wr, int wc, int fr, int fq) const {
        const int row0 = u.pm * BM + wr * 64 + fr, col0 = u.pn * BM + wc * 32 + 8 * fq;
        if (bias) {
#pragma unroll
            for (int bj = 0; bj < 2; ++bj)
#pragma unroll
                for (int n = 0; n < 2; ++n) { const f32x4 bv = *(const f32x4*)(bias + col0 + bj * HALF + 4 * n);
#pragma unroll
                    for (int ai = 0; ai < 2; ++ai)
#pragma unroll
                        for (int m = 0; m < 4; ++m) acc[ai][bj][m][n] += bv; }
        }
#pragma unroll
        for (int ai = 0; ai < 2; ++ai)
#pragma unroll
            for (int m = 0; m < 4; ++m) { float q = 0.f;
#pragma unroll
                for (int bj = 0; bj < 2; ++bj)
#pragma unroll
                    for (int n = 0; n < 2; ++n) { const f32x4 x = acc[ai][bj][m][n]; q += (x[0] * x[0] + x[1] * x[1]) + (x[2] * x[2] + x[3] * x[3]); }
                q += __shfl_xor(q, 16); q += __shfl_xor(q, 32);
                if (fq == 0) __hip_atomic_fetch_add(ss1 + row0 + ai * HALF + m * 16, q, __ATOMIC_RELAXED, __HIP_MEMORY_SCOPE_AGENT); }
        u32x4 rpre[2][4][2];
        if (res_bf16) {
#pragma unroll
            for (int ai = 0; ai < 2; ++ai)
#pragma unroll
                for (int m = 0; m < 4; ++m)
#pragma unroll
                    for (int bj = 0; bj < 2; ++bj) rpre[ai][m][bj] = *(const u32x4*)(res_bf16 + (size_t)(row0 + ai * HALF + m * 16) * D + col0 + bj * HALF);
        }
        xcd_barrier(*bar);
        float rs[2][4];
#pragma unroll
        for (int ai = 0; ai < 2; ++ai)
#pragma unroll
            for (int m = 0; m < 4; ++m) rs[ai][m] = ss1[row0 + ai * HALF + m * 16];
        f32x4 gp[2][2];
#pragma unroll
        for (int bj = 0; bj < 2; ++bj)
#pragma unroll
            for (int n = 0; n < 2; ++n) gp[bj][n] = *(const f32x4*)(gpost + col0 + bj * HALF + 4 * n);
#pragma unroll
        for (int ai = 0; ai < 2; ++ai)
#pragma unroll
            for (int m = 0; m < 4; ++m) { const int row = row0 + ai * HALF + m * 16;
                const float r = alpha * __builtin_amdgcn_rsqf(rs[ai][m] * (1.0f / D) + EPS);
                float q = 0.f;
#pragma unroll
                for (int bj = 0; bj < 2; ++bj) { const size_t off = (size_t)row * D + col0 + bj * HALF;
                    f32x4 r0, r1;
                    if (res_bf16) { const u32x4 t = rpre[ai][m][bj]; r0 = (f32x4){bf_lo(t.x), bf_hi(t.x), bf_lo(t.y), bf_hi(t.y)}; r1 = (f32x4){bf_lo(t.z), bf_hi(t.z), bf_lo(t.w), bf_hi(t.w)}; }
                    else { r0 = *(const f32x4*)(res_f32 + off); r1 = *(const f32x4*)(res_f32 + off + 4); }
                    const f32x4 h0 = r0 + acc[ai][bj][m][0] * r * gp[bj][0], h1 = r1 + acc[ai][bj][m][1] * r * gp[bj][1];
                    q += (h0[0] * h0[0] + h0[1] * h0[1]) + (h0[2] * h0[2] + h0[3] * h0[3]) + (h1[0] * h1[0] + h1[1] * h1[1]) + (h1[2] * h1[2] + h1[3] * h1[3]);
                    if (hb) { u32x4 w; w.x = pk2(h0[0], h0[1]); w.y = pk2(h0[2], h0[3]); w.z = pk2(h1[0], h1[1]); w.w = pk2(h1[2], h1[3]); *(u32x4*)(hb + off) = w; }
                    else { *(f32x4*)(out + off) = h0; *(f32x4*)(out + off + 4) = h1; } }
                if (ss2) { q += __shfl_xor(q, 16); q += __shfl_xor(q, 32);
                    if (fq == 0) __hip_atomic_fetch_add(ss2 + row, q, __ATOMIC_RELAXED, __HIP_MEMORY_SCOPE_AGENT); } }
    }
};
struct EpiWin {
    static constexpr bool PERM = true, AFTER_DRAIN = false;
    bf16_t* GC; bf16_t* A2; const LAS float* bias; const float* rowss; const LAS float* rtab; int pm0;
    __device__ __forceinline__ void operator()(const Acc& acc, const Unit& u, int wr, int wc, int fr, int fq) const {
        const int row0 = u.pm * BM + wr * 64 + fr;
        if (u.pn < 4) {
            const int col0 = u.pn * HALF + wc * 32 + 8 * fq;
            f32x4 bvv[2], bvg[2];
#pragma unroll
            for (int n = 0; n < 2; ++n) { bvv[n] = *(const LAS f32x4*)(bias + col0 + 4 * n); bvg[n] = *(const LAS f32x4*)(bias + 512 + col0 + 4 * n); }
#pragma unroll
            for (int ai = 0; ai < 2; ++ai)
#pragma unroll
                for (int m = 0; m < 4; ++m) { const int row = row0 + ai * HALF + m * 16; bf16_t* rowp = GC + (size_t)row * DC + col0;
                    const float r = u.pm == pm0 ? rtab[row - pm0 * BM] : __builtin_amdgcn_rsqf(rowss[row] * (1.0f / D) + EPS);
                    float v[8];
#pragma unroll
                    for (int n = 0; n < 2; ++n)
#pragma unroll
                        for (int j = 0; j < 4; ++j) v[4 * n + j] = (acc[ai][0][m][n][j] * r + bvv[n][j]) * sigmoid_f(acc[ai][1][m][n][j] * r + bvg[n][j]);
                    u32x4 w; w.x = pk2(v[0], v[1]); w.y = pk2(v[2], v[3]); w.z = pk2(v[4], v[5]); w.w = pk2(v[6], v[7]);
                    *(u32x4*)rowp = w; }
        } else {
#pragma unroll
            for (int bj = 0; bj < 2; ++bj) {
                const int s = (u.pn - 4) * BM + bj * HALF + wc * 32 + 8 * fq;
                const int gg = s >> 4, h0 = s & 15;
                const f32x4 b0 = *(const LAS f32x4*)(bias + 1024 + s), b1 = *(const LAS f32x4*)(bias + 1024 + s + 4);
#pragma unroll
                for (int ai = 0; ai < 2; ++ai)
#pragma unroll
                    for (int m = 0; m < 4; ++m) { const int t = row0 + ai * HALF + m * 16;
                        const float r = u.pm == pm0 ? rtab[t - pm0 * BM] : __builtin_amdgcn_rsqf(rowss[t] * (1.0f / D) + EPS);
                        const f32x4 v0 = acc[ai][bj][m][0] * r + b0, v1 = acc[ai][bj][m][1] * r + b1;
                        u32x4 w; w.x = pk2(v0[0], v0[1]); w.y = pk2(v0[2], v0[3]); w.z = pk2(v1[0], v1[1]); w.w = pk2(v1[2], v1[3]);
                        *(u32x4*)(A2 + ((size_t)(gg * 512 + (t >> 5)) * 768 + (t & 31) * 16 + h0)) = w; }
            }
        }
    }
};
struct EpiS2 {
    static constexpr bool PERM = true, AFTER_DRAIN = false;
    bf16_t* YG;
    __device__ __forceinline__ void operator()(const Acc& acc, const Unit& u, int wr, int wc, int fr, int fq) const {
        const int row0 = u.pm * BM + wr * 64 + fr;
#pragma unroll
        for (int bj = 0; bj < 2; ++bj) {
            const int col = u.pn * BM + bj * HALF + wc * 32 + 8 * fq, l = col >> 4, h0 = col & 15;
#pragma unroll
            for (int ai = 0; ai < 2; ++ai)
#pragma unroll
                for (int m = 0; m < 4; ++m) { const int row = row0 + ai * HALF + m * 16, gg = row >> 9, chunk = row & 511;
                    float v[8];
#pragma unroll
                    for (int n = 0; n < 2; ++n)
#pragma unroll
                        for (int j = 0; j < 4; ++j) v[4 * n + j] = gelu_tanh_f(acc[ai][bj][m][n][j]);
                    u32x4 w; w.x = pk2(v[0], v[1]); w.y = pk2(v[2], v[3]); w.z = pk2(v[4], v[5]); w.w = pk2(v[6], v[7]);
                    *(u32x4*)(YG + ((size_t)(chunk * 32 + l) * DS + gg * 16 + h0)) = w; }
        }
    }
};
struct EpiGlu {
    static constexpr bool PERM = true, AFTER_DRAIN = false;
    const bf16_t* YG; bf16_t* CAT; const float* bias; const float* og;
    __device__ __forceinline__ void operator()(const Acc& acc, const Unit& u, int wr, int wc, int fr, int fq) const {
        const int row0 = u.pm * BM + wr * 64 + fr, hl = u.pn * BM + wc * 64 + 8 * fq;
        f32x4 bz[2][2], gz[2][2];
#pragma unroll
        for (int bj = 0; bj < 2; ++bj)
#pragma unroll
            for (int n = 0; n < 2; ++n) { bz[bj][n] = *(const f32x4*)(bias + hl + 32 * bj + 4 * n); gz[bj][n] = *(const f32x4*)(og + hl + 32 * bj + 4 * n); }
#pragma unroll
        for (int ai = 0; ai < 2; ++ai)
#pragma unroll
            for (int m = 0; m < 4; ++m) { const int row = row0 + ai * HALF + m * 16;
                float v[2][8]; float ss = 0.f;
#pragma unroll
                for (int bj = 0; bj < 2; ++bj) { const u32x4 yv = *(const u32x4*)(YG + (size_t)row * DS + hl + 32 * bj);
                    const float y[8] = {bf_lo(yv.x), bf_hi(yv.x), bf_lo(yv.y), bf_hi(yv.y), bf_lo(yv.z), bf_hi(yv.z), bf_lo(yv.w), bf_hi(yv.w)};
#pragma unroll
                    for (int n = 0; n < 2; ++n)
#pragma unroll
                        for (int j = 0; j < 4; ++j) { const float z = acc[ai][bj][m][n][j] + bz[bj][n][j]; const float o = y[4 * n + j] * sigmoid_f(z); v[bj][4 * n + j] = o; ss += o * o; } }
                ss += __shfl_xor(ss, 16); ss += __shfl_xor(ss, 32);
                const float r = __builtin_amdgcn_rsqf(ss * (1.0f / 64.0f) + EPS);
#pragma unroll
                for (int bj = 0; bj < 2; ++bj) { u32x4 w;
                    w.x = pk2(v[bj][0] * r * gz[bj][0][0], v[bj][1] * r * gz[bj][0][1]); w.y = pk2(v[bj][2] * r * gz[bj][0][2], v[bj][3] * r * gz[bj][0][3]);
                    w.z = pk2(v[bj][4] * r * gz[bj][1][0], v[bj][5] * r * gz[bj][1][1]); w.w = pk2(v[bj][6] * r * gz[bj][1][2], v[bj][7] * r * gz[bj][1][3]);
                    *(u32x4*)(CAT + (size_t)row * D + 512 + hl + 32 * bj) = w; } }
    }
};
}

__device__ __forceinline__ void tr_item(const float* W, int K, int N, bf16_t* WT, int k0, int n0, int drow0, const float* rg, LAS float* scr, int lane) {
    { const int kr = lane >> 3, n4 = lane & 7; f32x4 v[8];
#pragma unroll
      for (int i = 0; i < 8; ++i) v[i] = *(const f32x4*)(W + (size_t)(k0 + kr + 8 * i) * N + n0 + 4 * n4);
#pragma unroll
      for (int i = 0; i < 8; ++i) { const float gk = rg ? rg[k0 + kr + 8 * i] : 1.0f;
          LAS float* d = scr + (kr + 8 * i) * 33 + 4 * n4; d[0] = v[i].x * gk; d[1] = v[i].y * gk; d[2] = v[i].z * gk; d[3] = v[i].w * gk; } }
    asm volatile("s_waitcnt lgkmcnt(0)" ::: "memory");
    const int c = lane & 7;
#pragma unroll
    for (int j = 0; j < 4; ++j) { const int n = (lane >> 3) + 8 * j; const LAS float* s = scr + (8 * c) * 33 + n;
        u32x4 o; o.x = pk2(s[0 * 33], s[1 * 33]); o.y = pk2(s[2 * 33], s[3 * 33]); o.z = pk2(s[4 * 33], s[5 * 33]); o.w = pk2(s[6 * 33], s[7 * 33]);
        *(u32x4*)(WT + (size_t)(drow0 + n) * K + k0 + 8 * c) = o; }
    asm volatile("s_waitcnt lgkmcnt(0)" ::: "memory");
}
__device__ __forceinline__ int drow_of(int mode, int n0) {
    if (mode == 1) return 256 * (n0 >> 7) + (n0 & 127);
    if (mode == 2) return 256 * (n0 >> 7) + 128 + (n0 & 127);
    if (mode == 3) { if (n0 < 512) return 256 * (n0 >> 7) + (n0 & 127); if (n0 < 1024) { const int n1 = n0 - 512; return 256 * (n1 >> 7) + 128 + (n1 & 127); } return n0; }
    if (mode == 4) { const int pn = n0 >> 8, r = n0 & 255, wc = r >> 6, bj = (r & 63) >> 5; return 256 * pn + 128 * bj + 32 * wc; }
    return n0;
}
__device__ __forceinline__ void tr_matrix_item(const float* W, int K, int N, bf16_t* WT, int mode, const float* rg, int item, LAS float* scr, int lane) {
    const int nblk = N / 32, kb = item / nblk, nb = item % nblk;
    tr_item(W, K, N, WT, 64 * kb, 32 * nb, drow_of(mode, 32 * nb), rg, scr, lane);
}

struct TrDesc { const float* W; bf16_t* WT; const float* rg; int K, N, mode, end; };
__device__ __forceinline__ void set_desc(LAS TrDesc* d, const float* W, bf16_t* WT, int K, int N, int mode, int end, const float* rg = nullptr) { d->W = W; d->WT = WT; d->rg = rg; d->K = K; d->N = N; d->mode = mode; d->end = end; }
__device__ __forceinline__ void tr_range(const LAS TrDesc* desc, int kfirst, int item_lo, int item_hi, int w0, int wstride, LAS float* scr, int lane) {
    for (int it = item_lo + w0; it < item_hi; it += wstride) {
        int k = kfirst; while (it >= desc[k].end) ++k;
        k = __builtin_amdgcn_readfirstlane(k);
        const int base = k ? desc[k - 1].end : 0;
        const unsigned long long wq = (unsigned long long)desc[k].W, tq = (unsigned long long)desc[k].WT, gq = (unsigned long long)desc[k].rg;
        const float* rg = (const float*)(((unsigned long long)(unsigned)__builtin_amdgcn_readfirstlane((int)(gq >> 32)) << 32) | (unsigned)__builtin_amdgcn_readfirstlane((int)gq));
        const float* W = (const float*)(((unsigned long long)(unsigned)__builtin_amdgcn_readfirstlane((int)(wq >> 32)) << 32) | (unsigned)__builtin_amdgcn_readfirstlane((int)wq));
        bf16_t* WT = (bf16_t*)(((unsigned long long)(unsigned)__builtin_amdgcn_readfirstlane((int)(tq >> 32)) << 32) | (unsigned)__builtin_amdgcn_readfirstlane((int)tq));
        const int K = __builtin_amdgcn_readfirstlane(desc[k].K), N = __builtin_amdgcn_readfirstlane(desc[k].N), mode = __builtin_amdgcn_readfirstlane(desc[k].mode);
        tr_matrix_item(W, K, N, WT, mode, rg, it - __builtin_amdgcn_readfirstlane(base), scr, lane);
    }
}

__device__ __forceinline__ void norm_rows(const float* x, const float* gpre, bf16_t* uout, int gw, int NGW, int lane) {
    for (int m = gw; m < T; m += 2 * NGW) {
        const int m2 = m + NGW; const bool has2 = m2 < T; const int mm2 = has2 ? m2 : m;
        const f32x4* r1 = (const f32x4*)(x + (size_t)m * D) + lane; const f32x4* r2 = (const f32x4*)(x + (size_t)mm2 * D) + lane;
        f32x4 h1[4], h2[4]; float s1 = 0.f, s2 = 0.f;
#pragma unroll
        for (int j = 0; j < 4; ++j) { h1[j] = r1[64 * j]; h2[j] = r2[64 * j]; }
#pragma unroll
        for (int j = 0; j < 4; ++j) { s1 += (h1[j].x * h1[j].x + h1[j].y * h1[j].y) + (h1[j].z * h1[j].z + h1[j].w * h1[j].w); s2 += (h2[j].x * h2[j].x + h2[j].y * h2[j].y) + (h2[j].z * h2[j].z + h2[j].w * h2[j].w); }
#pragma unroll
        for (int o = 1; o < 64; o <<= 1) { s1 += __shfl_xor(s1, o); s2 += __shfl_xor(s2, o); }
        const float q1 = 1.0f / sqrtf(s1 * (1.0f / D) + EPS), q2 = 1.0f / sqrtf(s2 * (1.0f / D) + EPS);
        u32x2* u1 = (u32x2*)(uout + (size_t)m * D) + lane; u32x2* u2 = (u32x2*)(uout + (size_t)mm2 * D) + lane;
#pragma unroll
        for (int j = 0; j < 4; ++j) { const f32x4 gp = ((const f32x4*)gpre)[lane + 64 * j]; const f32x4 o1 = h1[j] * q1 * gp, o2 = h2[j] * q2 * gp;
            u32x2 w; w.x = pk2(o1.x, o1.y); w.y = pk2(o1.z, o1.w); u1[64 * j] = w;
            if (has2) { u32x2 v; v.x = pk2(o2.x, o2.y); v.y = pk2(o2.z, o2.w); u2[64 * j] = v; } }
    }
}
template <bool RES_BF16, bool OUT_BF16, bool WRITE_U>
__device__ __forceinline__ void row_pass(const void* res, const bf16_t* f, const float* gpost, float alpha, void* hout, const float* gpre, bf16_t* uout, int gw, int NGW, int lane) {
    for (int m = gw; m < T; m += NGW) {
        f32x4 h[4];
        if (RES_BF16) { const u32x2* rr = (const u32x2*)((const bf16_t*)res + (size_t)m * D) + lane;
#pragma unroll
            for (int j = 0; j < 4; ++j) { const u32x2 q = rr[64 * j]; h[j] = (f32x4){bf_lo(q.x), bf_hi(q.x), bf_lo(q.y), bf_hi(q.y)}; } }
        else { const f32x4* rr = (const f32x4*)((const float*)res + (size_t)m * D) + lane;
#pragma unroll
            for (int j = 0; j < 4; ++j) h[j] = rr[64 * j]; }
        const u32x2* fr2 = (const u32x2*)(f + (size_t)m * D) + lane;
        f32x4 fv[4]; float ss = 0.f;
#pragma unroll
        for (int j = 0; j < 4; ++j) { const u32x2 q = fr2[64 * j]; fv[j] = (f32x4){bf_lo(q.x), bf_hi(q.x), bf_lo(q.y), bf_hi(q.y)};
            ss += (fv[j].x * fv[j].x + fv[j].y * fv[j].y) + (fv[j].z * fv[j].z + fv[j].w * fv[j].w); }
        const float rstd = alpha / sqrtf(wave_sum(ss) * (1.0f / D) + EPS);
#pragma unroll
        for (int j = 0; j < 4; ++j) { const f32x4 gp = ((const f32x4*)gpost)[lane + 64 * j]; h[j] = h[j] + fv[j] * rstd * gp; }
        if (OUT_BF16) { u32x2* ho = (u32x2*)((bf16_t*)hout + (size_t)m * D) + lane;
#pragma unroll
            for (int j = 0; j < 4; ++j) { u32x2 w; w.x = pk2(h[j].x, h[j].y); w.y = pk2(h[j].z, h[j].w); ho[64 * j] = w; } }
        else { f32x4* ho = (f32x4*)((float*)hout + (size_t)m * D) + lane;
#pragma unroll
            for (int j = 0; j < 4; ++j) ho[64 * j] = h[j]; }
        if (WRITE_U) {
            float s2 = 0.f;
#pragma unroll
            for (int j = 0; j < 4; ++j) s2 += (h[j].x * h[j].x + h[j].y * h[j].y) + (h[j].z * h[j].z + h[j].w * h[j].w);
            const float r2 = 1.0f / sqrtf(wave_sum(s2) * (1.0f / D) + EPS);
            u32x2* uo = (u32x2*)(uout + (size_t)m * D) + lane;
#pragma unroll
            for (int j = 0; j < 4; ++j) { const f32x4 gp = ((const f32x4*)gpre)[lane + 64 * j]; const f32x4 o = h[j] * r2 * gp;
                u32x2 w; w.x = pk2(o.x, o.y); w.y = pk2(o.z, o.w); uo[64 * j] = w; }
        }
    }
}

struct SsmIn { const float *lam_re, *lam_im, *log_step, *b_re, *b_im, *c_re, *c_im; };
__device__ __forceinline__ void ssm_tables_item(const SsmIn si, int g, int dir, int jq, float* Ktab, bf16_t* Wst, bf16_t* B2, float* adec, LAS float* sc, int tid) {
    LAS float* apow = sc;
    LAS float* Bb = sc + 1152;
    LAS float* Cc = sc + 1152 + 2048;
    const int gd = g * 2 + dir;
    LAS float* qtab = sc + 1152 + 4096 + 128 * 65 * 2;
    float braw[2], biraw[2];
#pragma unroll
    for (int r = 0; r < 2; ++r) { const int idx = tid + 512 * r; braw[r] = si.b_re[g * 1024 + idx]; biraw[r] = si.b_im[g * 1024 + idx];
        Cc[idx * 2] = si.c_re[g * 1024 + idx]; Cc[idx * 2 + 1] = si.c_im[g * 1024 + idx]; }
    if (tid < 64) {
        const int p = tid; const float step = expf(si.log_step[g]);
        const float lr = si.lam_re[g * 64 + p], li = si.lam_im[g * 64 + p];
        float s1, c1, s0, c0;
        double th = (double)li * (double)step; const double th1 = th - 6.283185307179586 * floor(th * 0.15915494309189535);
        sincosf((float)th1, &s1, &c1);
        const float mag1 = expf(lr * step), a1r = mag1 * c1, a1i = mag1 * s1;
        th *= (double)(8 * jq); th -= 6.283185307179586 * floor(th * 0.15915494309189535);
        sincosf((float)th, &s0, &c0);
        const float mag0 = expf(lr * step * (float)(8 * jq)); float pr = mag0 * c0, pi = mag0 * s0;
#pragma unroll
        for (int jj = 0; jj < 9; ++jj) { apow[(jj * 64 + p) * 2] = pr; apow[(jj * 64 + p) * 2 + 1] = pi; const float nr = pr * a1r - pi * a1i, ni = pr * a1i + pi * a1r; pr = nr; pi = ni; }
        const float ar = a1r - 1.0f, ai = a1i, inv = 1.0f / (lr * lr + li * li);
        qtab[2 * p] = (ar * lr + ai * li) * inv; qtab[2 * p + 1] = (ai * lr - ar * li) * inv;
    }
    __syncthreads();
#pragma unroll
    for (int r = 0; r < 2; ++r) { const int idx = tid + 512 * r, p = idx >> 4; const float qr = qtab[2 * p], qi = qtab[2 * p + 1];
        Bb[idx * 2] = qr * braw[r] - qi * biraw[r]; Bb[idx * 2 + 1] = qr * biraw[r] + qi * braw[r]; }
    LAS float* ACs = sc + 1152 + 4096;
#pragma unroll 4
    for (int r = 0; r < 16; ++r) { const int idx = tid + 512 * r, p = idx & 63, jh = idx >> 6, jj = jh >> 4, h = jh & 15;
        const float ar = apow[(jj * 64 + p) * 2], ai = apow[(jj * 64 + p) * 2 + 1], cr = Cc[(h * 64 + p) * 2], ci = Cc[(h * 64 + p) * 2 + 1];
        *(LAS f32x2*)(ACs + (jh * 65 + p) * 2) = (f32x2){ar * cr - ai * ci, ar * ci + ai * cr}; }
    __syncthreads();
    { const int jh = tid >> 2, q = tid & 3;
      f32x4 o = {0.f, 0.f, 0.f, 0.f};
#pragma unroll 8
      for (int p = 0; p < 64; ++p) { const f32x2 ac = *(const LAS f32x2*)(ACs + (jh * 65 + p) * 2);
          const f32x4 b01 = *(const LAS f32x4*)(Bb + (p * 16 + 4 * q) * 2), b23 = *(const LAS f32x4*)(Bb + (p * 16 + 4 * q + 2) * 2);
          o.x += ac.x * b01.x - ac.y * b01.y; o.y += ac.x * b01.z - ac.y * b01.w; o.z += ac.x * b23.x - ac.y * b23.y; o.w += ac.x * b23.z - ac.y * b23.w; }
      *(f32x4*)(Ktab + ((size_t)(gd * 32 + 8 * jq + (jh >> 4)) * 16 + (jh & 15)) * 16 + 4 * q) = o; }
    { const int jj = tid >> 6, p = tid & 63, j = 8 * jq + jj, lp = dir == 0 ? 31 - j : j;
      const float ar = apow[(jj * 64 + p) * 2], ai = apow[(jj * 64 + p) * 2 + 1];
      unsigned wr[8], wi[8];
#pragma unroll
      for (int q = 0; q < 8; ++q) { const f32x4 b = *(const LAS f32x4*)(Bb + (p * 16 + 2 * q) * 2);
          wr[q] = pk2(ar * b.x - ai * b.y, ar * b.z - ai * b.w); wi[q] = pk2(ar * b.y + ai * b.x, ar * b.w + ai * b.z); }
      bf16_t* o = Wst + (size_t)(g * 256 + dir * 128 + 2 * p) * 512 + lp * 16;
      *(u32x4*)o = (u32x4){wr[0], wr[1], wr[2], wr[3]}; *(u32x4*)(o + 8) = (u32x4){wr[4], wr[5], wr[6], wr[7]};
      *(u32x4*)(o + 512) = (u32x4){wi[0], wi[1], wi[2], wi[3]}; *(u32x4*)(o + 520) = (u32x4){wi[4], wi[5], wi[6], wi[7]}; }
#pragma unroll
    for (int r = 0; r < 4; ++r) { const int idx = tid + 512 * r, pq = idx & 15, h = (idx >> 4) & 15, jj = idx >> 8, e = 8 * jq + jj + 1, l = dir == 0 ? e - 1 : 32 - e;
        const f32x4 a01 = *(const LAS f32x4*)(apow + ((jj + 1) * 64 + 4 * pq) * 2), a23 = *(const LAS f32x4*)(apow + ((jj + 1) * 64 + 4 * pq + 2) * 2);
        const f32x4 c01 = *(const LAS f32x4*)(Cc + (h * 64 + 4 * pq) * 2), c23 = *(const LAS f32x4*)(Cc + (h * 64 + 4 * pq + 2) * 2);
        u32x4 w;
        w.x = pk2(c01.x * a01.x - c01.y * a01.y, -(c01.x * a01.y + c01.y * a01.x)); w.y = pk2(c01.z * a01.z - c01.w * a01.w, -(c01.z * a01.w + c01.w * a01.z));
        w.z = pk2(c23.x * a23.x - c23.y * a23.y, -(c23.x * a23.y + c23.y * a23.x)); w.w = pk2(c23.z * a23.z - c23.w * a23.w, -(c23.z * a23.w + c23.w * a23.z));
        *(u32x4*)(B2 + (size_t)(g * 512 + l * 16 + h) * 768 + 512 + dir * 128 + 8 * pq) = w; }
    if (jq == 3 && tid < 64) { adec[(gd * 64 + tid) * 2] = apow[(8 * 64 + tid) * 2]; adec[(gd * 64 + tid) * 2 + 1] = apow[(8 * 64 + tid) * 2 + 1]; }
    __syncthreads();
}
__device__ __forceinline__ void toeplitz_items(const float* Ktab, const float* ssm_d, bf16_t* B2, int gt, int NGT) {
#pragma unroll 4
    for (int item = gt; item < 16384 * 64; item += NGT) {
        const int n = item >> 6, kc = (item & 63) * 8, lp = kc >> 4, hp0 = kc & 15, g = n >> 9, l = (n >> 4) & 31, h = n & 15;
        const int jf = l - lp > 0 ? l - lp : 0, jb = lp - l > 0 ? lp - l : 0;
        const float mf = lp <= l ? 1.f : 0.f, mb = lp >= l ? 1.f : 0.f;
        const f32x4* kf = (const f32x4*)(Ktab + ((size_t)((g * 2 + 0) * 32 + jf) * 16 + h) * 16 + hp0);
        const f32x4* kb = (const f32x4*)(Ktab + ((size_t)((g * 2 + 1) * 32 + jb) * 16 + h) * 16 + hp0);
        const f32x4 f0 = kf[0], f1 = kf[1], b0 = kb[0], b1 = kb[1];
        const float d = (lp == l && (h >> 3) == (hp0 >> 3)) ? ssm_d[g * 16 + h] : 0.f;
        f32x4 v0 = f0 * mf + b0 * mb, v1 = f1 * mf + b1 * mb;
        const int i = h & 7;
        v0.x += i == 0 ? d : 0.f; v0.y += i == 1 ? d : 0.f; v0.z += i == 2 ? d : 0.f; v0.w += i == 3 ? d : 0.f;
        v1.x += i == 4 ? d : 0.f; v1.y += i == 5 ? d : 0.f; v1.z += i == 6 ? d : 0.f; v1.w += i == 7 ? d : 0.f;
        u32x4 w; w.x = pk2(v0.x, v0.y); w.y = pk2(v0.z, v0.w); w.z = pk2(v1.x, v1.y); w.w = pk2(v1.z, v1.w);
        *(u32x4*)(B2 + (size_t)n * 768 + kc) = w;
    }
}
__device__ __forceinline__ void conv_tile(const bf16_t* GC, const float* cw, const float* cb, const float* lng, const float* lnb, const float* og, bf16_t* CAT, LAS float* sc, int tile, int tid, int lane, int wave) {
    const int t0 = tile * 32, half = tid >> 8, cp = tid & 255, c = 2 * cp;
    const int tb = t0 + half * 16, lseq = tb & (SEQ - 1);
    unsigned in[46];
#pragma unroll
    for (int i = 0; i < 46; ++i) { const int tt = lseq - 15 + i; in[i] = (tt >= 0 && tt < SEQ) ? *(const unsigned*)(GC + (size_t)(tb - 15 + i) * DC + c) : 0u; }
    float a0[16], a1[16];
    { const f32x2 b = *(const f32x2*)(cb + c);
#pragma unroll
      for (int o = 0; o < 16; ++o) { a0[o] = b.x; a1[o] = b.y; } }
#pragma unroll
    for (int k = 0; k < 31; ++k) { const f32x2 w = *(const f32x2*)(cw + k * DC + c);
#pragma unroll
        for (int o = 0; o < 16; ++o) { a0[o] += w.x * bf_lo(in[o + k]); a1[o] += w.y * bf_hi(in[o + k]); } }
#pragma unroll
    for (int o = 0; o < 16; ++o) *(LAS f32x2*)(sc + (half * 16 + o) * 512 + c) = (f32x2){a0[o], a1[o]};
    __syncthreads();
    const int c8 = 8 * lane;
    const f32x4 g0 = *(const f32x4*)(lng + c8), g1 = *(const f32x4*)(lng + c8 + 4), b0 = *(const f32x4*)(lnb + c8), b1 = *(const f32x4*)(lnb + c8 + 4);
    const f32x4 o0 = *(const f32x4*)(og + c8), o1 = *(const f32x4*)(og + c8 + 4);
#pragma unroll
    for (int q = 0; q < 4; ++q) { const int tok = 4 * wave + q;
        f32x4 x0 = *(const LAS f32x4*)(sc + tok * 512 + c8), x1 = *(const LAS f32x4*)(sc + tok * 512 + c8 + 4);
        const float mean = wave_sum((x0.x + x0.y) + (x0.z + x0.w) + (x1.x + x1.y) + (x1.z + x1.w)) * (1.0f / 512.0f);
        x0 = x0 - mean; x1 = x1 - mean;
        const float var = wave_sum((x0.x * x0.x + x0.y * x0.y) + (x0.z * x0.z + x0.w * x0.w) + (x1.x * x1.x + x1.y * x1.y) + (x1.z * x1.z + x1.w * x1.w)) * (1.0f / 512.0f);
        const float rstd = 1.0f / sqrtf(var + EPS);
        x0 = x0 * rstd * g0 + b0; x1 = x1 * rstd * g1 + b1;
        float y[8] = {silu_f(x0.x), silu_f(x0.y), silu_f(x0.z), silu_f(x0.w), silu_f(x1.x), silu_f(x1.y), silu_f(x1.z), silu_f(x1.w)};
        float ss = 0.f;
#pragma unroll
        for (int j = 0; j < 8; ++j) ss += y[j] * y[j];
        ss = sum8_dpp(ss);
        const float r = 1.0f / sqrtf(ss * (1.0f / 64.0f) + EPS);
        u32x4 w; w.x = pk2(y[0] * r * o0.x, y[1] * r * o0.y); w.y = pk2(y[2] * r * o0.z, y[3] * r * o0.w); w.z = pk2(y[4] * r * o1.x, y[5] * r * o1.y); w.w = pk2(y[6] * r * o1.z, y[7] * r * o1.w);
        *(u32x4*)(CAT + (size_t)(t0 + tok) * D + c8) = w; }
    __syncthreads();
}
__device__ __forceinline__ void scan_item(const float* X, const float* adec, bf16_t* A2, int item, int lane) {
    const int g = item >> 3, b = (item >> 1) & 3, dir = item & 1, p = lane;
    const f32x2 ad = *(const f32x2*)(adec + ((g * 2 + dir) * 64 + p) * 2);
    const int row0 = g * 512 + b * 128;
    const float* xp = X + (size_t)row0 * 256 + dir * 128 + 2 * p;
    bf16_t* sp = A2 + (size_t)row0 * 768 + 512 + dir * 128 + 2 * p;
    float sr = 0.f, si = 0.f;
    f32x2 xa[16], xb[16]; unsigned ob[16];
#define SCAN_LOAD(buf, cb) do { _Pragma("unroll") for (int i = 0; i < 16; ++i) { const int c = dir == 0 ? (cb) + i : 127 - ((cb) + i); buf[i] = *(const f32x2*)(xp + (size_t)c * 256); } } while (0)
#define SCAN_STEP(buf) do { _Pragma("unroll") for (int i = 0; i < 16; ++i) { ob[i] = pk2(sr, si); \
        const float nr = ad.x * sr - ad.y * si + buf[i].x, ni = ad.x * si + ad.y * sr + buf[i].y; sr = nr; si = ni; } } while (0)
#define SCAN_STORE(cb) do { _Pragma("unroll") for (int i = 0; i < 16; ++i) { const int c = dir == 0 ? (cb) + i : 127 - ((cb) + i); *(unsigned*)(sp + (size_t)c * 768) = ob[i]; } } while (0)
    SCAN_LOAD(xa, 0); SCAN_LOAD(xb, 16);
#pragma unroll 1
    for (int cb = 0; cb < 128; cb += 32) {
        SCAN_STEP(xa); if (cb + 32 < 128) SCAN_LOAD(xa, cb + 32); SCAN_STORE(cb);
        SCAN_STEP(xb); if (cb + 48 < 128) SCAN_LOAD(xb, cb + 48); SCAN_STORE(cb + 16);
    }
#undef SCAN_STORE
#undef SCAN_LOAD
#undef SCAN_STEP
}

struct Args { const float* in[40]; float* out; unsigned char* ws; int lo, hi; };

__global__ void __launch_bounds__(512, 2) hybrid_fwd(Args a) {
    extern __shared__ __attribute__((aligned(16))) unsigned char lds_raw[];
    LAS unsigned char* lds = (LAS unsigned char*)lds_raw;
    LAS float* ldsf = (LAS float*)lds_raw;
    cg::grid_group grid = cg::this_grid();
    const int tid = threadIdx.x, lane = tid & 63, wave = __builtin_amdgcn_readfirstlane(tid >> 6);
    const int G = gridDim.x, bid = blockIdx.x;
    const int gw = bid * 8 + wave, NGW = G * 8;
    const int lo = a.lo, hi = a.hi;
    unsigned char* ws = a.ws;
    bf16_t* Wgu1 = (bf16_t*)(ws + WS_WGU1); bf16_t* Wd1 = (bf16_t*)(ws + WS_WD1); bf16_t* Wgu2 = (bf16_t*)(ws + WS_WGU2); bf16_t* Wd2 = (bf16_t*)(ws + WS_WD2);
    bf16_t* Win = (bf16_t*)(ws + WS_WIN); bf16_t* Wglu = (bf16_t*)(ws + WS_WGLU); bf16_t* Wout = (bf16_t*)(ws + WS_WOUT);
    bf16_t* B2 = (bf16_t*)(ws + WS_B2); bf16_t* Wst = (bf16_t*)(ws + WS_WST); float* Ktab = (float*)(ws + WS_KTAB); float* adec = (float*)(ws + WS_ADEC);
    bf16_t* U = (bf16_t*)(ws + WS_U); bf16_t* F = (bf16_t*)(ws + WS_F); bf16_t* ACT = (bf16_t*)(ws + WS_ACT);
    bf16_t* GC = (bf16_t*)(ws + WS_GC); bf16_t* A2 = (bf16_t*)(ws + WS_A2); float* X = (float*)(ws + WS_X); bf16_t* YG = (bf16_t*)(ws + WS_YG);
    bf16_t* CAT = U;
    bf16_t* HB = (bf16_t*)(ws + WS_HB);
#define IN(k) (lo <= (k) && (k) < hi)
    volatile LAS unsigned* bst = (volatile LAS unsigned*)(lds + LDS_CTL);
    LAS TrDesc* desc = (LAS TrDesc*)(lds + LDS_CTL + 64);
    constexpr int I_G = (D / 64) * (DFF / 32), I_D = (DFF / 64) * (D / 32), I_IN = (D / 64) * (DIN / 32), I_GLU = (DS / 64) * (DS / 32), I_O = (D / 64) * (D / 32);
    constexpr int C0 = I_G, C1 = C0 + I_G, C2 = C1 + I_D, C3 = C2 + I_IN, C4 = C3 + I_G, C5 = C4 + I_G, C6 = C5 + I_D, C7 = C6 + I_GLU, C8 = C7 + I_O;
    if (tid == 0) { bst[0] = 0u; bst[1] = 0u;
        set_desc(desc + 0, a.in[2], (bf16_t*)(ws + WS_WGU1), D, DFF, 1, C0);  set_desc(desc + 1, a.in[3], (bf16_t*)(ws + WS_WGU1), D, DFF, 2, C1);  set_desc(desc + 2, a.in[4], (bf16_t*)(ws + WS_WD1), DFF, D, 0, C2);
        set_desc(desc + 3, a.in[7], (bf16_t*)(ws + WS_WIN), D, DIN, 3, C3, a.in[6]);
        set_desc(desc + 4, a.in[36], (bf16_t*)(ws + WS_WGU2), D, DFF, 1, C4, a.in[35]); set_desc(desc + 5, a.in[37], (bf16_t*)(ws + WS_WGU2), D, DFF, 2, C5, a.in[35]);
        set_desc(desc + 6, a.in[38], (bf16_t*)(ws + WS_WD2), DFF, D, 0, C6); set_desc(desc + 7, a.in[29], (bf16_t*)(ws + WS_WGLU), DS, DS, 4, C7); set_desc(desc + 8, a.in[32], (bf16_t*)(ws + WS_WOUT), D, D, 0, C8); }
    __syncthreads();
    XcdBarrier xbar; xbar.bar = (unsigned*)(ws + WS_BAR); xbar.x = 0; xbar.st = bst;
    if (hi - lo > 1) xbar = xcd_barrier_post((unsigned*)(ws + WS_BAR), bst);
#ifndef CG_SEAM
#define CG_SEAM 0
#endif
    if (hi > NPH) grid.sync();
#define SEAM(k) do { if (IN(k) && IN((k) + 1)) xcd_barrier(xbar); } while (0)

#define TAIL_VARS const bool tailwg = (G == 256) ? (bid >= 128) : true; const int tgw = (G == 256) ? (bid - 128) * 8 + wave : gw, TNGW = (G == 256) ? 128 * 8 : NGW; const int tb = (G == 256) ? bid - 128 : bid, TG = (G == 256) ? 128 : G; LAS float* scr = ldsf + wave * (64 * 33)
    if (IN(0)) {
#pragma unroll 1
        for (int pass = 0; pass < 3; ++pass) {
            if (pass == 1) {
                tr_range(desc, 0, 0, C1, gw, NGW, ldsf + wave * (64 * 33), lane);
                norm_rows(a.in[0], a.in[1], U, gw, NGW, lane);
                __syncthreads();
            } else if ((pass == 0) == ((bid & 1) != 0)) {
                for (int it = bid; it < 256; it += G) {
                    const int gd = it >> 2, jq = it & 3, g = gd >> 1, dir = gd & 1;
                    const SsmIn si{dir ? a.in[21] : a.in[14], dir ? a.in[22] : a.in[15], dir ? a.in[23] : a.in[16], dir ? a.in[24] : a.in[17], dir ? a.in[25] : a.in[18], dir ? a.in[26] : a.in[19], dir ? a.in[27] : a.in[20]};
                    ssm_tables_item(si, g, dir, jq, Ktab, Wst, B2, adec, ldsf, tid);
                }
            }
        }
    }
    SEAM(0);
    if (IN(1)) {
        pg8::Gemm g{U, Wgu1, D, D, D}; pg8::Sched S; S.init(0, T, 2 * DFF, G, bid);
        pg8::EpiSwiGLU E{ACT, DFF, nullptr, nullptr, -1};
        pg8::gemm_phase(lds, g, S, E);
        TAIL_VARS;
        if (tailwg) tr_range(desc, 2, C1, C3, tgw, TNGW, scr, lane);
    }
    SEAM(1);
    float* SS = (float*)(ws + WS_SS);
    if (IN(2)) {
        pg8::Gemm g{ACT, Wd1, DFF, DFF, DFF}; pg8::Sched S; S.init(0, T, D, G, bid);
        pg8::EpiNormRes E{a.in[0], nullptr, 0.5f, a.in[5], nullptr, SS, SS + T, HB, nullptr, &xbar};
        pg8::gemm_phase(lds, g, S, E);
    }
    SEAM(2);
    if (IN(4)) {
        pg8::Gemm g{HB, Win, D, D, D}; pg8::Sched S; S.init(0, T, DIN, G, bid);
        LAS float* rtab = (LAS float*)(lds + pg8::STAGE_BYTES);
        pg8::Unit u0; const int pm0 = S.next(0, u0) ? u0.pm : -1;
        if (pm0 >= 0 && tid < 256) rtab[tid] = __builtin_amdgcn_rsqf(SS[T + pm0 * 256 + tid] * (1.0f / D) + EPS);
        LAS float* lbias = rtab + 256;
        for (int i = tid; i < DIN; i += 512) lbias[i] = a.in[8][i];
        __syncthreads();
        pg8::EpiWin E{GC, A2, lbias, SS + T, rtab, pm0};
        pg8::gemm_phase(lds, g, S, E);
        TAIL_VARS;
        if (tailwg) {
            tr_range(desc, 4, C3, C5, tgw, TNGW, scr, lane);
            toeplitz_items(Ktab, a.in[28], B2, tb * 512 + tid, TG * 512);
        }
    }
    SEAM(4);
    if (IN(5)) {
        if (bid < 64) {
            pg8::Gemm g{A2, Wst, 768, 512, 512}; pg8::Sched S; S.init(1, 0, 0, 64, bid);
            pg8::EpiXScan E{lds, adec, A2};
            pg8::gemm_phase(lds, g, S, E);
        } else {
            for (int tile = bid - 64; tile < 384; tile += G - 64) conv_tile(GC, a.in[9], a.in[10], a.in[11], a.in[12], a.in[13], CAT, ldsf, tile, tid, lane, wave);
        }
    }
    SEAM(6);
    if (IN(7)) {
        pg8::Gemm g{A2, B2, 768, 768, 768}; pg8::Sched S; S.init(2, 0, 0, G, bid);
        pg8::EpiS2 E{YG};
        pg8::gemm_phase(lds, g, S, E);
        TAIL_VARS;
        if (G == 256 && bid >= 128) conv_tile(GC, a.in[9], a.in[10], a.in[11], a.in[12], a.in[13], CAT, ldsf, 384 + bid - 128, tid, lane, wave);
        if (tailwg) tr_range(desc, 6, C5, C8, tgw, TNGW, scr, lane);
    }
    SEAM(7);
    if (IN(8)) {
        pg8::Gemm g{YG, Wglu, DS, DS, DS}; pg8::Sched S; S.init(0, T, DS, G, bid);
        pg8::EpiGlu E{YG, CAT, a.in[30], a.in[31]};
        pg8::gemm_phase(lds, g, S, E);
    }
    SEAM(8);
    if (IN(9)) {
        pg8::Gemm g{CAT, Wout, D, D, D}; pg8::Sched S; S.init(0, T, D, G, bid);
        pg8::EpiNormRes E{nullptr, HB, 1.0f, a.in[34], a.in[33], SS + 2 * T, SS + 3 * T, HB, nullptr, &xbar};
        pg8::gemm_phase(lds, g, S, E);
    }
    SEAM(9);
    if (IN(11)) {
        pg8::Gemm g{HB, Wgu2, D, D, D}; pg8::Sched S; S.init(0, T, 2 * DFF, G, bid);
        LAS float* rtab = (LAS float*)(lds + pg8::STAGE_BYTES);
        pg8::Unit u0; const int pm0 = S.next(0, u0) ? u0.pm : -1;
        if (pm0 >= 0 && tid < 256) rtab[tid] = __builtin_amdgcn_rsqf(SS[3 * T + pm0 * 256 + tid] * (1.0f / D) + EPS);
        __syncthreads();
        pg8::EpiSwiGLU E{ACT, DFF, SS + 3 * T, rtab, pm0};
        pg8::gemm_phase(lds, g, S, E);
    }
    SEAM(11);
    if (IN(12)) {
        pg8::Gemm g{ACT, Wd2, DFF, DFF, DFF}; pg8::Sched S; S.init(0, T, D, G, bid);
        pg8::EpiNormRes E{nullptr, HB, 0.5f, a.in[39], nullptr, SS + 4 * T, nullptr, nullptr, a.out, &xbar};
        pg8::gemm_phase(lds, g, S, E);
    }
#undef IN
#undef SEAM
}

extern "C" void kernel_launch(void* const* d_in, const int* in_sizes, int n_in, void* d_out, int out_size, void* d_ws, size_t ws_size, hipStream_t stream) {
    constexpr int LDS_BYTES = LDS_CTL + 512;
    static int grid = 0;
    if (grid == 0) {
        int dev = 0, cus = 0, per_cu = 0;
        if (n_in != 40 || ws_size < WS_END) { fprintf(stderr, "kernel_launch: unexpected n_in %d / ws_size %zu (need %zu)\n", n_in, ws_size, (size_t)WS_END); grid = -1; return; }
        hipGetDevice(&dev);
        hipDeviceGetAttribute(&cus, hipDeviceAttributeMultiprocessorCount, dev);
        if (hipFuncSetAttribute((const void*)hybrid_fwd, hipFuncAttributeMaxDynamicSharedMemorySize, LDS_BYTES) != hipSuccess) { fprintf(stderr, "kernel_launch: hipFuncSetAttribute failed\n"); grid = -1; return; }
        if (hipOccupancyMaxActiveBlocksPerMultiprocessor(&per_cu, (const void*)hybrid_fwd, 512, LDS_BYTES) != hipSuccess || per_cu < 1) { fprintf(stderr, "kernel_launch: occupancy query failed (%d)\n", per_cu); (void)hipGetLastError(); per_cu = 1; }
        if (cus != 256) { fprintf(stderr, "kernel_launch: built for a 256-CU device (one 256x256 unit per workgroup in the fused-norm GEMM phases); got %d CUs\n", cus); grid = -1; return; }
        grid = cus * 1;
        if (grid <= 0) grid = 256;
    }
    if (grid < 0) return;
    if (hipMemsetAsync((unsigned char*)d_ws + WS_BAR, 0, ZERO_BYTES, stream) != hipSuccess) { fprintf(stderr, "kernel_launch: hipMemsetAsync failed\n"); return; }
    Args a{};
    for (int i = 0; i < 40; ++i) a.in[i] = (const float*)d_in[i];
    a.out = (float*)d_out; a.ws = (unsigned char*)d_ws;
    a.lo = 0; a.hi = NPH;
    void* args[] = {&a};
    hipError_t e = hipLaunchCooperativeKernel((const void*)hybrid_fwd, dim3(grid), dim3(512), args, LDS_BYTES, stream);
    if (e != hipSuccess) fprintf(stderr, "kernel_launch: cooperative launch failed: %s (grid %d)\n", hipGetErrorString(e), grid);
}
```

```cpp
#include <hip/hip_runtime.h>
#include <hip/hip_cooperative_groups.h>
#include <cstdio>
namespace cg = cooperative_groups;


#define LAS __attribute__((address_space(3)))
typedef unsigned short bf16_t;
typedef short bf16x8 __attribute__((ext_vector_type(8)));
typedef float f32x4 __attribute__((ext_vector_type(4)));
typedef float f32x2 __attribute__((ext_vector_type(2)));
typedef unsigned u32x4 __attribute__((ext_vector_type(4)));
typedef unsigned u32x2 __attribute__((ext_vector_type(2)));

constexpr int T = 16384, D = 1024, DFF = 2816, DIN = 1536, DC = 512, DS = 512, SEQ = 4096;
constexpr int NPH = 14;
constexpr int LDS_CTL = 136 * 1024;
constexpr float EPS = 1e-6f;

constexpr size_t SZ_WGU = (size_t)2 * DFF * D * 2, SZ_WD = (size_t)D * DFF * 2;
constexpr size_t WS_WGU1 = 0, WS_WD1 = WS_WGU1 + SZ_WGU, WS_WGU2 = WS_WGU1, WS_WD2 = WS_WD1;
constexpr size_t WS_HB = WS_WD1 + SZ_WD;
constexpr size_t WS_WIN = WS_HB + (size_t)T * D * 2, WS_WGLU = WS_WIN + (size_t)DIN * D * 2, WS_WOUT = WS_WGLU + (size_t)DS * DS * 2;
constexpr size_t WS_B2 = WS_WOUT + (size_t)D * D * 2;
constexpr size_t WS_WST = WS_B2 + (size_t)16384 * 768 * 2;
constexpr size_t WS_KTAB = WS_WST + (size_t)8192 * 512 * 2;
constexpr size_t WS_ADEC = WS_KTAB + (size_t)64 * 32 * 256 * 4;
constexpr size_t WS_U = WS_ADEC + (size_t)64 * 64 * 2 * 4;
constexpr size_t WS_F = WS_U + (size_t)T * D * 2;
constexpr size_t WS_ACT = WS_F + (size_t)T * D * 2;
constexpr size_t WS_GC = WS_ACT;
constexpr size_t WS_A2 = WS_GC + (size_t)T * DC * 2;
constexpr size_t WS_X = WS_A2 + (size_t)16384 * 768 * 2;
constexpr size_t WS_YG = WS_X + (size_t)16384 * 256 * 4;
constexpr size_t WS_BAR = WS_ACT + (size_t)T * DFF * 2;
constexpr size_t WS_SS = WS_BAR + 16384;
constexpr size_t WS_END = WS_SS + (size_t)6 * T * 4;
constexpr size_t ZERO_BYTES = WS_END - WS_BAR;
static_assert(WS_YG + (size_t)T * DS * 2 <= WS_BAR, "mixer aliases fit");
static_assert(WS_END <= (size_t)256 * 1024 * 1024, "workspace");

__device__ __forceinline__ unsigned pk2(float lo, float hi) { unsigned r; asm volatile("v_cvt_pk_bf16_f32 %0, %1, %2" : "=v"(r) : "v"(lo), "v"(hi)); return r; }
__device__ __forceinline__ float bf_lo(unsigned v) { return __uint_as_float(v << 16); }
__device__ __forceinline__ float bf_hi(unsigned v) { return __uint_as_float(v & 0xffff0000u); }
__device__ __forceinline__ float sigmoid_f(float x) { return __builtin_amdgcn_rcpf(1.0f + __builtin_amdgcn_exp2f(-1.4426950408889634f * x)); }
__device__ __forceinline__ float silu_f(float x) { return x * sigmoid_f(x); }
__device__ __forceinline__ float gelu_tanh_f(float x) { return x * sigmoid_f(1.5957691216057308f * (x + 0.044715f * x * x * x)); }
template <int CTRL> __device__ __forceinline__ float dpp_f(float v) { return __builtin_bit_cast(float, __builtin_amdgcn_update_dpp(0, __builtin_bit_cast(int, v), CTRL, 0xF, 0xF, true)); }
__device__ __forceinline__ float sum8_dpp(float v) {
    v += dpp_f<0xB1>(v);
    v += dpp_f<0x4E>(v);
    v += dpp_f<0x141>(v);
    return v;
}
__device__ __forceinline__ float wave_sum(float v) {
    v = sum8_dpp(v);
    v += dpp_f<0x140>(v);
    const int iv = __builtin_bit_cast(int, v);
    const float r0 = __builtin_bit_cast(float, __builtin_amdgcn_readlane(iv, 0)), r1 = __builtin_bit_cast(float, __builtin_amdgcn_readlane(iv, 16));
    const float r2 = __builtin_bit_cast(float, __builtin_amdgcn_readlane(iv, 32)), r3 = __builtin_bit_cast(float, __builtin_amdgcn_readlane(iv, 48));
    return (r0 + r1) + (r2 + r3);
}

#define XB_TMO      128
#define XB_XCNT(j)  (256  + 64 * (j))
#define XB_XSUB(j)  (1280 + 64 * (j))
#define XB_XGEN(j)  (2304 + 64 * (j))
#define XB_TOP      3328
#define XB_TOPGEN   3392
#define XCD_BAR_WORDS 3456
#define XB_SPIN_CAP (1u << 18)
__device__ __forceinline__ unsigned xb_ld(unsigned* p)              { return __hip_atomic_load(p, __ATOMIC_RELAXED, __HIP_MEMORY_SCOPE_AGENT); }
__device__ __forceinline__ unsigned xb_add(unsigned* p, unsigned v) { return __hip_atomic_fetch_add(p, v, __ATOMIC_RELAXED, __HIP_MEMORY_SCOPE_AGENT); }
__device__ __forceinline__ unsigned xb_xcc_id() { return (unsigned)__builtin_amdgcn_s_getreg((3 << 11) | 20) & 0xFu; }
#define XB_SPIN(cond, bar) do { unsigned _sp = 0; while (cond) { __builtin_amdgcn_s_sleep(1); \
    if ((++_sp & 255u) == 0u) { if (xb_ld(&(bar)[XB_TMO])) break; if (_sp > XB_SPIN_CAP) { atomicAdd(&(bar)[XB_TMO], 1u); break; } } } } while (0)
struct XcdBarrier { unsigned* bar; unsigned x; volatile LAS unsigned* st; };
__device__ __forceinline__ XcdBarrier xcd_barrier_post(unsigned* bar, volatile LAS unsigned* st) {
    XcdBarrier b; b.bar = bar; b.x = xb_xcc_id(); b.st = st;
    if (threadIdx.x == 0) (void)xb_add(&bar[XB_XCNT(b.x)], 1u);
    return b;
}
__device__ __forceinline__ void xcd_barrier_complete(unsigned* bar, unsigned x, unsigned& nloc, unsigned& nx) {
    const unsigned G = gridDim.x * gridDim.y * gridDim.z;
    unsigned sum, cnt, mine, sp = 0u;
    for (;;) {
        sum = 0u; cnt = 0u; mine = 0u;
#pragma unroll
        for (unsigned j = 0; j < 16; ++j) { const unsigned c = xb_ld(&bar[XB_XCNT(j)]); sum += c; cnt += (c > 0u) ? 1u : 0u; mine = (j == x) ? c : mine; }
        if (sum == G) break;
        __builtin_amdgcn_s_sleep(1);
        if ((++sp & 255u) == 0u) { if (xb_ld(&bar[XB_TMO])) break; if (sp > XB_SPIN_CAP) { atomicAdd(&bar[XB_TMO], 1u); break; } }
    }
    nloc = mine > 0u ? mine : 1u; nx = cnt > 0u ? cnt : 1u;
}
__device__ __forceinline__ void xcd_barrier(const XcdBarrier& b) {
    asm volatile("s_waitcnt vmcnt(0)" ::: "memory");
    __syncthreads();
    if (threadIdx.x == 0) {
        unsigned* bar = b.bar;
        __builtin_amdgcn_s_waitcnt(0);
        unsigned nloc = b.st[0], nx = b.st[1];
        if (nloc == 0u) { xcd_barrier_complete(bar, b.x, nloc, nx); b.st[0] = nloc; b.st[1] = nx; }
        const unsigned old = xb_add(&bar[XB_XSUB(b.x)], 1u);
        const unsigned gen = old / nloc;
        if (old + 1u == (gen + 1u) * nloc) {
            __builtin_amdgcn_fence(__ATOMIC_RELEASE, "agent");
            asm volatile("s_waitcnt vmcnt(0)" ::: "memory");
            const unsigned og = xb_add(&bar[XB_TOP], 1u);
            const unsigned tg = og / nx;
            if (og + 1u == (tg + 1u) * nx) xb_add(&bar[XB_TOPGEN], 1u);
            else XB_SPIN(xb_ld(&bar[XB_TOPGEN]) == tg, bar);
            __builtin_amdgcn_fence(__ATOMIC_ACQUIRE, "agent");
            xb_add(&bar[XB_XGEN(b.x)], 1u);
            asm volatile("s_waitcnt vmcnt(0)" ::: "memory");
        } else {
            XB_SPIN(xb_ld(&bar[XB_XGEN(b.x)]) == gen, bar);
            __builtin_amdgcn_fence(__ATOMIC_ACQUIRE, "agent");
            asm volatile("s_waitcnt vmcnt(0)" ::: "memory");
        }
    }
    __syncthreads();
}

namespace pg8 {
constexpr int BM = 256, BK = 64, HALF = 128, HTB = HALF * BK * 2, STAGE_BYTES = 8 * HTB, NXCD = 8, WGM = 8;
__host__ __device__ __forceinline__ int lds_byte(int r, int c) { const int st = (r >> 4) * 2 + (c >> 5), rr = r & 15, cc = c & 31, ob = rr * 64 + cc * 2; return st * 1024 + (ob ^ (((ob >> 9) & 1) << 5)); }
__host__ __device__ __forceinline__ void stage_rc(int b, int& R, int& C) { const int st = b / 1024, sb = b % 1024, swz = sb ^ (((sb >> 9) & 1) << 5); R = (st >> 1) * 16 + swz / 64; C = (st & 1) * 32 + (swz % 64) / 2; }
__host__ __device__ __forceinline__ int perm32(int rho) { const int n = rho >> 4, i = rho & 15; return 8 * (i >> 2) + 4 * n + (i & 3); }

struct Unit { int pm, pn, pb; };
struct Gemm { const bf16_t* A; const bf16_t* Bt; int lda, ldb, K; };

struct Sched {
    int mode, nM, nN, nwg, G, c;
    __device__ __forceinline__ void init(int mode_, int M, int N, int G_, int c_) { mode = mode_; nM = M / BM; nN = N / BM; nwg = nM * nN; G = G_; c = c_; }
    __device__ __forceinline__ bool next(int i, Unit& u) const {
        const long L = (long)i * G + c;
        if (mode == 1) { if (L >= 64) return false; u.pm = (int)L; u.pn = 0; u.pb = (int)L >> 1; return true; }
        if (mode == 2) { if (L >= 128) return false; u.pm = (int)L >> 1; u.pn = (int)L & 1; u.pb = (u.pm >> 1) * 2 + u.pn; return true; }
        if (L >= nwg) return false;
        int wgid = (int)L; { const int q = nwg / NXCD, r = nwg % NXCD, xcd = wgid % NXCD, off = wgid / NXCD; wgid = (xcd < r ? xcd * (q + 1) : r * (q + 1) + (xcd - r) * q) + off; }
        const int nig = WGM * nN, gid = wgid / nig, fm = gid * WGM, gsz = (nM - fm) < WGM ? (nM - fm) : WGM;
        u.pm = fm + ((wgid % nig) % gsz); u.pn = (wgid % nig) / gsz; u.pb = u.pn; return true;
    }
};

typedef f32x4 Acc[2][2][4][2];

template <class Epi>
__device__ __forceinline__ void gemm_phase(LAS unsigned char* lds, const Gemm g, const Sched& S, const Epi& E) {
    const int tid = threadIdx.x, wid = __builtin_amdgcn_readfirstlane(tid >> 6), lane = tid & 63, wr = wid >> 2, wc = wid & 3, fr = lane & 15, fq = lane >> 4;
    const int K = g.K, nt = K / BK;
    unsigned voffA[2], voffB[2];
#pragma unroll
    for (int i = 0; i < 2; ++i) { int R, C; stage_rc(tid * 16 + i * 8192, R, C); const int Rb = Epi::PERM ? ((R & ~31) + perm32(R & 31)) : R;
        voffA[i] = (unsigned)(R * g.lda + C) * 2u; voffB[i] = (unsigned)(Rb * g.ldb + C) * 2u; }
    const size_t kstep = (size_t)(BK * 2);
    const size_t hstepA = (size_t)HALF * g.lda * 2, hstepB = (size_t)HALF * g.ldb * 2;
    const size_t tstepA = 2 * hstepA, tstepB = 2 * hstepB;
    const unsigned ldsw = (unsigned)wid * 1024u;
    const int aoff = lds_byte(wr * 64 + fr, fq * 8), boff = lds_byte(wc * 32 + fr, fq * 8);
#define PG8_SA(b, h) (((b) * 2 + (h)) * HTB)
#define PG8_SB(b, h) ((4 + (b) * 2 + (h)) * HTB)
#define PG8_STAGE(bufoff, gbase, voff) do { _Pragma("unroll") for (int _i = 0; _i < 2; ++_i) \
        __builtin_amdgcn_global_load_lds((const unsigned*)((const char*)(gbase) + (voff)[_i]), (LAS unsigned*)(lds + (bufoff) + ldsw + _i * 8192), 16, 0, 0); } while (0)
#define PG8_LDA(dst, b, h) do { _Pragma("unroll") for (int m = 0; m < 4; ++m) _Pragma("unroll") for (int k = 0; k < 2; ++k) dst[m][k] = *(const LAS bf16x8*)(lds + PG8_SA(b, h) + aoff + m * 2048 + k * 1024); } while (0)
#define PG8_LDB(dst, b, h) do { _Pragma("unroll") for (int n = 0; n < 2; ++n) _Pragma("unroll") for (int k = 0; k < 2; ++k) dst[n][k] = *(const LAS bf16x8*)(lds + PG8_SB(b, h) + boff + n * 2048 + k * 1024); } while (0)
#define PG8_MMA(ai, bj, At, Bt) do { __builtin_amdgcn_s_setprio(1); _Pragma("unroll") for (int m = 0; m < 4; ++m) _Pragma("unroll") for (int n = 0; n < 2; ++n) _Pragma("unroll") for (int k = 0; k < 2; ++k) \
        acc[ai][bj][m][n] = __builtin_amdgcn_mfma_f32_16x16x32_bf16(Bt[n][k], At[m][k], acc[ai][bj][m][n], 0, 0, 0); __builtin_amdgcn_s_setprio(0); } while (0)
#define PG8_WAIT_V(n) asm volatile("s_waitcnt vmcnt(" #n ")" ::: "memory")
#define PG8_WAIT_L(n) asm volatile("s_waitcnt lgkmcnt(" #n ")" ::: "memory")
#define PG8_BAR __builtin_amdgcn_s_barrier()
#define PG8_SCHED __builtin_amdgcn_sched_barrier(0)
    Unit cur, nxt; int ui = 0;
    if (!S.next(0, cur)) return;
    Acc acc;
#pragma unroll
    for (int a = 0; a < 2; ++a)
#pragma unroll
        for (int b = 0; b < 2; ++b)
#pragma unroll
            for (int m = 0; m < 4; ++m)
#pragma unroll
                for (int n = 0; n < 2; ++n) acc[a][b][m][n] = (f32x4){0.f, 0.f, 0.f, 0.f};
    bf16x8 At[4][2], B0[2][2], B1[2][2];
    const char* cA = (const char*)g.A + (size_t)cur.pm * tstepA; const char* cB = (const char*)g.Bt + (size_t)cur.pb * tstepB;
    PG8_STAGE(PG8_SB(0, 0), cB, voffB); PG8_STAGE(PG8_SA(0, 0), cA, voffA); PG8_STAGE(PG8_SB(0, 1), cB + hstepB, voffB); PG8_STAGE(PG8_SA(0, 1), cA + hstepA, voffA);
    if (wr == 1) PG8_BAR;
    PG8_WAIT_V(4); PG8_BAR;
    PG8_STAGE(PG8_SB(1, 0), cB + kstep, voffB); PG8_STAGE(PG8_SA(1, 0), cA + kstep, voffA); PG8_STAGE(PG8_SB(1, 1), cB + hstepB + kstep, voffB);
    PG8_WAIT_V(6); PG8_BAR;
    for (;;) {
        const bool has_next = S.next(ui + 1, nxt);
        const char* nA = has_next ? (const char*)g.A + (size_t)nxt.pm * tstepA : cA; const char* nB = has_next ? (const char*)g.Bt + (size_t)nxt.pb * tstepB : cB;
        for (int t = 0; t < nt; t += 2) {
            const bool last = (t == nt - 2);
            const char* a1 = cA + (size_t)(t + 1) * kstep;
            const char* a2 = last ? nA : cA + (size_t)(t + 2) * kstep; const char* b2 = last ? nB : cB + (size_t)(t + 2) * kstep;
            const char* a3 = a2 + kstep; const char* b3 = b2 + kstep;
            PG8_LDB(B0, 0, 0); PG8_SCHED; PG8_LDA(At, 0, 0); PG8_STAGE(PG8_SA(1, 1), a1 + hstepA, voffA);
            PG8_WAIT_L(8); PG8_BAR; PG8_WAIT_L(0); PG8_MMA(0, 0, At, B0); PG8_BAR; PG8_SCHED;
            PG8_LDB(B1, 0, 1); PG8_STAGE(PG8_SB(0, 0), b2, voffB);
            PG8_BAR; PG8_WAIT_L(0); PG8_MMA(0, 1, At, B1); PG8_BAR;
            PG8_LDA(At, 0, 1); PG8_STAGE(PG8_SA(0, 0), a2, voffA);
            PG8_BAR; PG8_WAIT_L(0); PG8_MMA(1, 0, At, B0); PG8_BAR; PG8_SCHED;
            PG8_STAGE(PG8_SB(0, 1), b2 + hstepB, voffB);
            PG8_WAIT_V(6); PG8_BAR; PG8_MMA(1, 1, At, B1); PG8_BAR;
            PG8_LDB(B0, 1, 0); PG8_SCHED; PG8_LDA(At, 1, 0); PG8_STAGE(PG8_SA(0, 1), a2 + hstepA, voffA);
            PG8_WAIT_L(8); PG8_BAR; PG8_WAIT_L(0); PG8_MMA(0, 0, At, B0); PG8_BAR; PG8_SCHED;
            PG8_LDB(B1, 1, 1); PG8_STAGE(PG8_SB(1, 0), b3, voffB);
            PG8_BAR; PG8_WAIT_L(0); PG8_MMA(0, 1, At, B1); PG8_BAR;
            PG8_LDA(At, 1, 1); PG8_STAGE(PG8_SA(1, 0), a3, voffA);
            PG8_BAR; PG8_WAIT_L(0); PG8_MMA(1, 0, At, B0); PG8_BAR; PG8_SCHED;
            PG8_STAGE(PG8_SB(1, 1), b3 + hstepB, voffB);
            PG8_WAIT_V(6); PG8_BAR; PG8_MMA(1, 1, At, B1); PG8_BAR;
        }
        if constexpr (!Epi::AFTER_DRAIN) E(acc, cur, wr, wc, fr, fq);
        if (!has_next) break;
#pragma unroll
        for (int a = 0; a < 2; ++a)
#pragma unroll
            for (int b = 0; b < 2; ++b)
#pragma unroll
                for (int m = 0; m < 4; ++m)
#pragma unroll
                    for (int n = 0; n < 2; ++n) acc[a][b][m][n] = (f32x4){0.f, 0.f, 0.f, 0.f};
        cur = nxt; cA = nA; cB = nB; ++ui;
    }
    PG8_WAIT_V(0);
    if (wr == 0) PG8_BAR;
    PG8_BAR;
    if constexpr (Epi::AFTER_DRAIN) E.fused(acc, cur, wr, wc, fr, fq);
#undef PG8_SA
#undef PG8_SB
#undef PG8_STAGE
#undef PG8_LDA
#undef PG8_LDB
#undef PG8_MMA
#undef PG8_WAIT_V
#undef PG8_WAIT_L
#undef PG8_BAR
#undef PG8_SCHED
}

struct EpiBf16 {
    static constexpr bool PERM = true, AFTER_DRAIN = false;
    bf16_t* O; int ldc; const float* bias;
    __device__ __forceinline__ void operator()(const Acc& acc, const Unit& u, int wr, int wc, int fr, int fq) const {
        const int row0 = u.pm * BM + wr * 64 + fr, col0 = u.pn * BM + wc * 32 + 8 * fq;
        f32x4 bv[2][2];
#pragma unroll
        for (int bj = 0; bj < 2; ++bj)
#pragma unroll
            for (int n = 0; n < 2; ++n) bv[bj][n] = bias ? *(const f32x4*)(bias + col0 + bj * HALF + 4 * n) : (f32x4){0.f, 0.f, 0.f, 0.f};
#pragma unroll
        for (int ai = 0; ai < 2; ++ai)
#pragma unroll
            for (int m = 0; m < 4; ++m) { bf16_t* rowp = O + (size_t)(row0 + ai * HALF + m * 16) * ldc + col0;
#pragma unroll
                for (int bj = 0; bj < 2; ++bj) { const f32x4 v0 = acc[ai][bj][m][0] + bv[bj][0], v1 = acc[ai][bj][m][1] + bv[bj][1];
                    u32x4 w; w.x = pk2(v0[0], v0[1]); w.y = pk2(v0[2], v0[3]); w.z = pk2(v1[0], v1[1]); w.w = pk2(v1[2], v1[3]);
                    *(u32x4*)(rowp + bj * HALF) = w; } }
    }
};
struct EpiF32 {
    static constexpr bool PERM = false, AFTER_DRAIN = false;
    float* C; int ldc;
    __device__ __forceinline__ void operator()(const Acc& acc, const Unit& u, int wr, int wc, int fr, int fq) const {
        const int row0 = u.pm * BM + wr * 64 + fr, col0 = u.pn * BM + wc * 32 + 4 * fq;
#pragma unroll
        for (int ai = 0; ai < 2; ++ai)
#pragma unroll
            for (int m = 0; m < 4; ++m) { float* rowp = C + (size_t)(row0 + ai * HALF + m * 16) * ldc + col0;
#pragma unroll
                for (int bj = 0; bj < 2; ++bj)
#pragma unroll
                    for (int n = 0; n < 2; ++n) *(f32x4*)(rowp + bj * HALF + n * 16) = acc[ai][bj][m][n]; }
    }
};
struct EpiXScan {
    static constexpr bool PERM = false, AFTER_DRAIN = true;
    LAS unsigned char* lds; const float* adec; bf16_t* A2;
    __device__ __forceinline__ void operator()(const Acc&, const Unit&, int, int, int, int) const {}
    __device__ __forceinline__ void fused(Acc& acc, const Unit& u, int wr, int wc, int fr, int fq) const {
        constexpr int PITCH = 520;
#pragma unroll
        for (int ai = 0; ai < 2; ++ai)
#pragma unroll
            for (int m = 0; m < 4; ++m) { const int r = ai * HALF + wr * 64 + m * 16 + fr;
#pragma unroll
                for (int bj = 0; bj < 2; ++bj)
#pragma unroll
                    for (int n = 0; n < 2; ++n) { const int c = bj * HALF + wc * 32 + n * 16 + 4 * fq; const f32x4 v = acc[ai][bj][m][n];
                        u32x2 w; w.x = pk2(v[0], v[1]); w.y = pk2(v[2], v[3]); *(LAS u32x2*)(lds + r * PITCH + c * 2) = w; } }
        __syncthreads();
        const int wave = threadIdx.x >> 6, lane = threadIdx.x & 63;
        if (wave < 4) {
            const int bsel = wave >> 1, dir = wave & 1, g = u.pm >> 1, b = 2 * (u.pm & 1) + bsel;
            const f32x2 ad = *(const f32x2*)(adec + ((g * 2 + dir) * 64 + lane) * 2);
            bf16_t* sp = A2 + (size_t)(g * 512 + b * 128) * 768 + 512 + dir * 128 + 2 * lane;
            const LAS unsigned char* xp = lds + (128 * bsel) * PITCH + (dir * 128 + 2 * lane) * 2;
            float sr = 0.f, si = 0.f;
#pragma unroll 16
            for (int k = 0; k < 128; ++k) { const int c = dir == 0 ? k : 127 - k;
                const unsigned xv = *(const LAS unsigned*)(xp + c * PITCH);
                *(unsigned*)(sp + (size_t)c * 768) = pk2(sr, si);
                const float nr = ad.x * sr - ad.y * si + bf_lo(xv), ni = ad.x * si + ad.y * sr + bf_hi(xv); sr = nr; si = ni; }
        }
    }
};
struct EpiSwiGLU {
    static constexpr bool PERM = true, AFTER_DRAIN = false;
    bf16_t* O; int ldc; const float* rowss; const LAS float* rtab; int pm0;
    __device__ __forceinline__ void operator()(const Acc& acc, const Unit& u, int wr, int wc, int fr, int fq) const {
        const int row0 = u.pm * BM + wr * 64 + fr, col0 = u.pn * HALF + wc * 32 + 8 * fq;
#pragma unroll
        for (int ai = 0; ai < 2; ++ai)
#pragma unroll
            for (int m = 0; m < 4; ++m) { const int row = row0 + ai * HALF + m * 16; bf16_t* rowp = O + (size_t)row * ldc + col0;
                const float r = !rowss ? 1.0f : (u.pm == pm0 ? rtab[row - pm0 * BM] : __builtin_amdgcn_rsqf(rowss[row] * (1.0f / D) + EPS));
                float v[8];
#pragma unroll
                for (int n = 0; n < 2; ++n)
#pragma unroll
                    for (int j = 0; j < 4; ++j) v[4 * n + j] = silu_f(acc[ai][0][m][n][j] * r) * (acc[ai][1][m][n][j] * r);
                u32x4 w; w.x = pk2(v[0], v[1]); w.y = pk2(v[2], v[3]); w.z = pk2(v[4], v[5]); w.w = pk2(v[6], v[7]);
                *(u32x4*)rowp = w; }
    }
};
struct EpiNormRes {
    static constexpr bool PERM = true, AFTER_DRAIN = true;
    const float* res_f32; const bf16_t* res_bf16; float alpha; const float* gpost; const float* bias; float* ss1; float* ss2; bf16_t* hb; float* out; const XcdBarrier* bar;
    __device__ __forceinline__ void operator()(const Acc&, const Unit&, int, int, int, int) const {}
    __device__ __forceinline__ void fused(Acc& acc, const Unit& u, int wr, int wc, int fr, int fq) const {
        const int row0 = u.pm * BM + wr * 64 + fr, col0 = u.pn * BM + wc * 32 + 8 * fq;
        if (bias) {
#pragma unroll
            for (int bj = 0; bj < 2; ++bj)
#pragma unroll
                for (int n = 0; n < 2; ++n) { const f32x4 bv = *(const f32x4*)(bias + col0 + bj * HALF + 4 * n);
#pragma unroll
                    for (int ai = 0; ai < 2; ++ai)
#pragma unroll
                        for (int m = 0; m < 4; ++m) acc[ai][bj][m][n] += bv; }
        }
#pragma unroll
        for (int ai = 0; ai < 2; ++ai)
#pragma unroll
            for (int m = 0; m < 4; ++m) { float q = 0.f;
#pragma unroll
                for (int bj = 0; bj < 2; ++bj)
#pragma unroll
                    for (int n = 0; n < 2; ++n) { const f32x4 x = acc[ai][bj][m][n]; q += (x[0] * x[0] + x[1] * x[1]) + (x[2] * x[2] + x[3] * x[3]); }
                q += __shfl_xor(q, 16); q += __shfl_xor(q, 32);
                if (fq == 0) __hip_atomic_fetch_add(ss1 + row0 + ai * HALF + m * 16, q, __ATOMIC_RELAXED, __HIP_MEMORY_SCOPE_AGENT); }
        u32x4 rpre[2][4][2];
        if (res_bf16) {
#pragma unroll
            for (int ai = 0; ai < 2; ++ai)
#pragma unroll
                for (int m = 0; m < 4; ++m)
#pragma unroll
                    for (int bj = 0; bj < 2; ++bj) rpre[ai][m][bj] = *(const u32x4*)(res_bf16 + (size_t)(row0 + ai * HALF + m * 16) * D + col0 + bj * HALF);
        }
        xcd_barrier(*bar);
        float rs[2][4];
#pragma unroll
        for (int ai = 0; ai < 2; ++ai)
#pragma unroll
            for (int m = 0; m < 4; ++m) rs[ai][m] = ss1[row0 + ai * HALF + m * 16];
        f32x4 gp[2][2];
#pragma unroll
        for (int bj = 0; bj < 2; ++bj)
#pragma unroll
            for (int n = 0; n < 2; ++n) gp[bj][n] = *(const f32x4*)(gpost + col0 + bj * HALF + 4 * n);
#pragma unroll
        for (int ai = 0; ai < 2; ++ai)
#pragma unroll
            for (int m = 0; m < 4; ++m) { const int row = row0 + ai * HALF + m * 16;
                const float r = alpha * __builtin_amdgcn_rsqf(rs[ai][m] * (1.0f / D) + EPS);
                float q = 0.f;
#pragma unroll
                for (int bj = 0; bj < 2; ++bj) { const size_t off = (size_t)row * D + col0 + bj * HALF;
                    f32x4 r0, r1;
                    if (res_bf16) { const u32x4 t = rpre[ai][m][bj]; r0 = (f32x4){bf_lo(t.x), bf_hi(t.x), bf_lo(t.y), bf_hi(t.y)}; r1 = (f32x4){bf_lo(t.z), bf_hi(t.z), bf_lo(t.w), bf_hi(t.w)}; }
                    else { r0 = *(const f32x4*)(res_f32 + off); r1 = *(const f32x4*)(res_f32 + off + 4); }
                    const f32x4 h0 = r0 + acc[ai][bj][m][0] * r * gp[bj][0], h1 = r1 + acc[ai][bj][m][1] * r * gp[bj][1];
                    q += (h0[0] * h0[0] + h0[1] * h0[1]) + (h0[2] * h0[2] + h0[3] * h0[3]) + (h1[0] * h1[0] + h1[1] * h1[1]) + (h1[2] * h1[2] + h1[3] * h1[3]);
                    if (hb) { u32x4 w; w.x = pk2(h0[0], h0[1]); w.y = pk2(h0[2], h0[3]); w.z = pk2(h1[0], h1[1]); w.w = pk2(h1[2], h1[3]); *(u32x4*)(hb + off) = w; }
                    else { *(f32x4*)(out + off) = h0; *(f32x4*)(out + off + 4) = h1; } }
                if (ss2) { q += __shfl_xor(q, 16); q += __shfl_xor(q, 32);
                    if (fq == 0) __hip_atomic_fetch_add(ss2 + row, q, __ATOMIC_RELAXED, __HIP_MEMORY_SCOPE_AGENT); } }
    }
};
struct EpiWin {
    static constexpr bool PERM = true, AFTER_DRAIN = false;
    bf16_t* GC; bf16_t* A2; const LAS float* bias; const float* rowss; const LAS float* rtab; int pm0;
    __device__ __forceinline__ void operator()(const Acc& acc, const Unit& u, int wr, int wc, int fr, int fq) const {
        const int row0 = u.pm * BM + wr * 64 + fr;
        if (u.pn < 4) {
            const int col0 = u.pn * HALF + wc * 32 + 8 * fq;
            f32x4 bvv[2], bvg[2];
#pragma unroll
            for (int n = 0; n < 2; ++n) { bvv[n] = *(const LAS f32x4*)(bias + col0 + 4 * n); bvg[n] = *(const LAS f32x4*)(bias + 512 + col0 + 4 * n); }
#pragma unroll
            for (int ai = 0; ai < 2; ++ai)
#pragma unroll
                for (int m = 0; m < 4; ++m) { const int row = row0 + ai * HALF + m * 16; bf16_t* rowp = GC + (size_t)row * DC + col0;
                    const float r = u.pm == pm0 ? rtab[row - pm0 * BM] : __builtin_amdgcn_rsqf(rowss[row] * (1.0f / D) + EPS);
                    float v[8];
#pragma unroll
                    for (int n = 0; n < 2; ++n)
#pragma unroll
                        for (int j = 0; j < 4; ++j) v[4 * n + j] = (acc[ai][0][m][n][j] * r + bvv[n][j]) * sigmoid_f(acc[ai][1][m][n][j] * r + bvg[n][j]);
                    u32x4 w; w.x = pk2(v[0], v[1]); w.y = pk2(v[2], v[3]); w.z = pk2(v[4], v[5]); w.w = pk2(v[6], v[7]);
                    *(u32x4*)rowp = w; }
        } else {
#pragma unroll
            for (int bj = 0; bj < 2; ++bj) {
                const int s = (u.pn - 4) * BM + bj * HALF + wc * 32 + 8 * fq;
                const int gg = s >> 4, h0 = s & 15;
                const f32x4 b0 = *(const LAS f32x4*)(bias + 1024 + s), b1 = *(const LAS f32x4*)(bias + 1024 + s + 4);
#pragma unroll
                for (int ai = 0; ai < 2; ++ai)
#pragma unroll
                    for (int m = 0; m < 4; ++m) { const int t = row0 + ai * HALF + m * 16;
                        const float r = u.pm == pm0 ? rtab[t - pm0 * BM] : __builtin_amdgcn_rsqf(rowss[t] * (1.0f / D) + EPS);
                        const f32x4 v0 = acc[ai][bj][m][0] * r + b0, v1 = acc[ai][bj][m][1] * r + b1;
                        u32x4 w; w.x = pk2(v0[0], v0[1]); w.y = pk2(v0[2], v0[3]); w.z = pk2(v1[0], v1[1]); w.w = pk2(v1[2], v1[3]);
                        *(u32x4*)(A2 + ((size_t)(gg * 512 + (t >> 5)) * 768 + (t & 31) * 16 + h0)) = w; }
            }
        }
    }
};
struct EpiS2 {
    static constexpr bool PERM = true, AFTER_DRAIN = false;
    bf16_t* YG;
    __device__ __forceinline__ void operator()(const Acc& acc, const Unit& u, int wr, int wc, int fr, int fq) const {
        const int row0 = u.pm * BM + wr * 64 + fr;
#pragma unroll
        for (int bj = 0; bj < 2; ++bj) {
            const int col = u.pn * BM + bj * HALF + wc * 32 + 8 * fq, l = col >> 4, h0 = col & 15;
#pragma unroll
            for (int ai = 0; ai < 2; ++ai)
#pragma unroll
                for (int m = 0; m < 4; ++m) { const int row = row0 + ai * HALF + m * 16, gg = row >> 9, chunk = row & 511;
                    float v[8];
#pragma unroll
                    for (int n = 0; n < 2; ++n)
#pragma unroll
                        for (int j = 0; j < 4; ++j) v[4 * n + j] = gelu_tanh_f(acc[ai][bj][m][n][j]);
                    u32x4 w; w.x = pk2(v[0], v[1]); w.y = pk2(v[2], v[3]); w.z = pk2(v[4], v[5]); w.w = pk2(v[6], v[7]);
                    *(u32x4*)(YG + ((size_t)(chunk * 32 + l) * DS + gg * 16 + h0)) = w; }
        }
    }
};
struct EpiGlu {
    static constexpr bool PERM = true, AFTER_DRAIN = false;
    const bf16_t* YG; bf16_t* CAT; const float* bias; const float* og;
    __device__ __forceinline__ void operator()(const Acc& acc, const Unit& u, int wr, int wc, int fr, int fq) const {
        const int row0 = u.pm * BM + wr * 64 + fr, hl = u.pn * BM + wc * 64 + 8 * fq;
        f32x4 bz[2][2], gz[2][2];
#pragma unroll
        for (int bj = 0; bj < 2; ++bj)
#pragma unroll
            for (int n = 0; n < 2; ++n) { bz[bj][n] = *(const f32x4*)(bias + hl + 32 * bj + 4 * n); gz[bj][n] = *(const f32x4*)(og + hl + 32 * bj + 4 * n); }
#pragma unroll
        for (int ai = 0; ai < 2; ++ai)
#pragma unroll
            for (int m = 0; m < 4; ++m) { const int row = row0 + ai * HALF + m * 16;
                float v[2][8]; float ss = 0.f;
#pragma unroll
                for (int bj = 0; bj < 2; ++bj) { const u32x4 yv = *(const u32x4*)(YG + (size_t)row * DS + hl + 32 * bj);
                    const float y[8] = {bf_lo(yv.x), bf_hi(yv.x), bf_lo(yv.y), bf_hi(yv.y), bf_lo(yv.z), bf_hi(yv.z), bf_lo(yv.w), bf_hi(yv.w)};
#pragma unroll
                    for (int n = 0; n < 2; ++n)
#pragma unroll
                        for (int j = 0; j < 4; ++j) { const float z = acc[ai][bj][m][n][j] + bz[bj][n][j]; const float o = y[4 * n + j] * sigmoid_f(z); v[bj][4 * n + j] = o; ss += o * o; } }
                ss += __shfl_xor(ss, 16); ss += __shfl_xor(ss, 32);
                const float r = __builtin_amdgcn_rsqf(ss * (1.0f / 64.0f) + EPS);
#pragma unroll
                for (int bj = 0; bj < 2; ++bj) { u32x4 w;
                    w.x = pk2(v[bj][0] * r * gz[bj][0][0], v[bj][1] * r * gz[bj][0][1]); w.y = pk2(v[bj][2] * r * gz[bj][0][2], v[bj][3] * r * gz[bj][0][3]);
                    w.z = pk2(v[bj][4] * r * gz[bj][1][0], v[bj][5] * r * gz[bj][1][1]); w.w = pk2(v[bj][6] * r * gz[bj][1][2], v[bj][7] * r * gz[bj][1][3]);
                    *(u32x4*)(CAT + (size_t)row * D + 512 + hl + 32 * bj) = w; } }
    }
};
}

__device__ __forceinline__ void tr_item(const float* W, int K, int N, bf16_t* WT, int k0, int n0, int drow0, const float* rg, LAS float* scr, int lane) {
    { const int kr = lane >> 3, n4 = lane & 7; f32x4 v[8];
#pragma unroll
      for (int i = 0; i < 8; ++i) v[i] = *(const f32x4*)(W + (size_t)(k0 + kr + 8 * i) * N + n0 + 4 * n4);
#pragma unroll
      for (int i = 0; i < 8; ++i) { const float gk = rg ? rg[k0 + kr + 8 * i] : 1.0f;
          LAS float* d = scr + (kr + 8 * i) * 33 + 4 * n4; d[0] = v[i].x * gk; d[1] = v[i].y * gk; d[2] = v[i].z * gk; d[3] = v[i].w * gk; } }
    asm volatile("s_waitcnt lgkmcnt(0)" ::: "memory");
    const int c = lane & 7;
#pragma unroll
    for (int j = 0; j < 4; ++j) { const int n = (lane >> 3) + 8 * j; const LAS float* s = scr + (8 * c) * 33 + n;
        u32x4 o; o.x = pk2(s[0 * 33], s[1 * 33]); o.y = pk2(s[2 * 33], s[3 * 33]); o.z = pk2(s[4 * 33], s[5 * 33]); o.w = pk2(s[6 * 33], s[7 * 33]);
        *(u32x4*)(WT + (size_t)(drow0 + n) * K + k0 + 8 * c) = o; }
    asm volatile("s_waitcnt lgkmcnt(0)" ::: "memory");
}
__device__ __forceinline__ int drow_of(int mode, int n0) {
    if (mode == 1) return 256 * (n0 >> 7) + (n0 & 127);
    if (mode == 2) return 256 * (n0 >> 7) + 128 + (n0 & 127);
    if (mode == 3) { if (n0 < 512) return 256 * (n0 >> 7) + (n0 & 127); if (n0 < 1024) { const int n1 = n0 - 512; return 256 * (n1 >> 7) + 128 + (n1 & 127); } return n0; }
    if (mode == 4) { const int pn = n0 >> 8, r = n0 & 255, wc = r >> 6, bj = (r & 63) >> 5; return 256 * pn + 128 * bj + 32 * wc; }
    return n0;
}
__device__ __forceinline__ void tr_matrix_item(const float* W, int K, int N, bf16_t* WT, int mode, const float* rg, int item, LAS float* scr, int lane) {
    const int nblk = N / 32, kb = item / nblk, nb = item % nblk;
    tr_item(W, K, N, WT, 64 * kb, 32 * nb, drow_of(mode, 32 * nb), rg, scr, lane);
}

struct TrDesc { const float* W; bf16_t* WT; const float* rg; int K, N, mode, end; };
__device__ __forceinline__ void set_desc(LAS TrDesc* d, const float* W, bf16_t* WT, int K, int N, int mode, int end, const float* rg = nullptr) { d->W = W; d->WT = WT; d->rg = rg; d->K = K; d->N = N; d->mode = mode; d->end = end; }
__device__ __forceinline__ void tr_range(const LAS TrDesc* desc, int kfirst, int item_lo, int item_hi, int w0, int wstride, LAS float* scr, int lane) {
    for (int it = item_lo + w0; it < item_hi; it += wstride) {
        int k = kfirst; while (it >= desc[k].end) ++k;
        k = __builtin_amdgcn_readfirstlane(k);
        const int base = k ? desc[k - 1].end : 0;
        const unsigned long long wq = (unsigned long long)desc[k].W, tq = (unsigned long long)desc[k].WT, gq = (unsigned long long)desc[k].rg;
        const float* rg = (const float*)(((unsigned long long)(unsigned)__builtin_amdgcn_readfirstlane((int)(gq >> 32)) << 32) | (unsigned)__builtin_amdgcn_readfirstlane((int)gq));
        const float* W = (const float*)(((unsigned long long)(unsigned)__builtin_amdgcn_readfirstlane((int)(wq >> 32)) << 32) | (unsigned)__builtin_amdgcn_readfirstlane((int)wq));
        bf16_t* WT = (bf16_t*)(((unsigned long long)(unsigned)__builtin_amdgcn_readfirstlane((int)(tq >> 32)) << 32) | (unsigned)__builtin_amdgcn_readfirstlane((int)tq));
        const int K = __builtin_amdgcn_readfirstlane(desc[k].K), N = __builtin_amdgcn_readfirstlane(desc[k].N), mode = __builtin_amdgcn_readfirstlane(desc[k].mode);
        tr_matrix_item(W, K, N, WT, mode, rg, it - __builtin_amdgcn_readfirstlane(base), scr, lane);
    }
}

__device__ __forceinline__ void norm_rows(const float* x, float* ssx, bf16_t* uout, int gw, int NGW, int lane) {
    for (int m = gw; m < T; m += 2 * NGW) {
        const int m2 = m + NGW; const bool has2 = m2 < T; const int mm2 = has2 ? m2 : m;
        const f32x4* r1 = (const f32x4*)(x + (size_t)m * D) + lane; const f32x4* r2 = (const f32x4*)(x + (size_t)mm2 * D) + lane;
        f32x4 h1[4], h2[4]; float s1 = 0.f, s2 = 0.f;
#pragma unroll
        for (int j = 0; j < 4; ++j) { h1[j] = r1[64 * j]; h2[j] = r2[64 * j]; }
        u32x2* u1 = (u32x2*)(uout + (size_t)m * D) + lane; u32x2* u2 = (u32x2*)(uout + (size_t)mm2 * D) + lane;
#pragma unroll
        for (int j = 0; j < 4; ++j) { u32x2 w; w.x = pk2(h1[j].x, h1[j].y); w.y = pk2(h1[j].z, h1[j].w); u1[64 * j] = w;
            if (has2) { u32x2 v; v.x = pk2(h2[j].x, h2[j].y); v.y = pk2(h2[j].z, h2[j].w); u2[64 * j] = v; } }
#pragma unroll
        for (int j = 0; j < 4; ++j) { s1 += (h1[j].x * h1[j].x + h1[j].y * h1[j].y) + (h1[j].z * h1[j].z + h1[j].w * h1[j].w); s2 += (h2[j].x * h2[j].x + h2[j].y * h2[j].y) + (h2[j].z * h2[j].z + h2[j].w * h2[j].w); }
#pragma unroll
        for (int o = 1; o < 64; o <<= 1) { s1 += __shfl_xor(s1, o); s2 += __shfl_xor(s2, o); }
        if (lane == 0) { ssx[m] = s1; if (has2) ssx[m2] = s2; }
    }
}
template <bool RES_BF16, bool OUT_BF16, bool WRITE_U>
__device__ __forceinline__ void row_pass(const void* res, const bf16_t* f, const float* gpost, float alpha, void* hout, const float* gpre, bf16_t* uout, int gw, int NGW, int lane) {
    for (int m = gw; m < T; m += NGW) {
        f32x4 h[4];
        if (RES_BF16) { const u32x2* rr = (const u32x2*)((const bf16_t*)res + (size_t)m * D) + lane;
#pragma unroll
            for (int j = 0; j < 4; ++j) { const u32x2 q = rr[64 * j]; h[j] = (f32x4){bf_lo(q.x), bf_hi(q.x), bf_lo(q.y), bf_hi(q.y)}; } }
        else { const f32x4* rr = (const f32x4*)((const float*)res + (size_t)m * D) + lane;
#pragma unroll
            for (int j = 0; j < 4; ++j) h[j] = rr[64 * j]; }
        const u32x2* fr2 = (const u32x2*)(f + (size_t)m * D) + lane;
        f32x4 fv[4]; float ss = 0.f;
#pragma unroll
        for (int j = 0; j < 4; ++j) { const u32x2 q = fr2[64 * j]; fv[j] = (f32x4){bf_lo(q.x), bf_hi(q.x), bf_lo(q.y), bf_hi(q.y)};
            ss += (fv[j].x * fv[j].x + fv[j].y * fv[j].y) + (fv[j].z * fv[j].z + fv[j].w * fv[j].w); }
        const float rstd = alpha / sqrtf(wave_sum(ss) * (1.0f / D) + EPS);
#pragma unroll
        for (int j = 0; j < 4; ++j) { const f32x4 gp = ((const f32x4*)gpost)[lane + 64 * j]; h[j] = h[j] + fv[j] * rstd * gp; }
        if (OUT_BF16) { u32x2* ho = (u32x2*)((bf16_t*)hout + (size_t)m * D) + lane;
#pragma unroll
            for (int j = 0; j < 4; ++j) { u32x2 w; w.x = pk2(h[j].x, h[j].y); w.y = pk2(h[j].z, h[j].w); ho[64 * j] = w; } }
        else { f32x4* ho = (f32x4*)((float*)hout + (size_t)m * D) + lane;
#pragma unroll
            for (int j = 0; j < 4; ++j) ho[64 * j] = h[j]; }
        if (WRITE_U) {
            float s2 = 0.f;
#pragma unroll
            for (int j = 0; j < 4; ++j) s2 += (h[j].x * h[j].x + h[j].y * h[j].y) + (h[j].z * h[j].z + h[j].w * h[j].w);
            const float r2 = 1.0f / sqrtf(wave_sum(s2) * (1.0f / D) + EPS);
            u32x2* uo = (u32x2*)(uout + (size_t)m * D) + lane;
#pragma unroll
            for (int j = 0; j < 4; ++j) { const f32x4 gp = ((const f32x4*)gpre)[lane + 64 * j]; const f32x4 o = h[j] * r2 * gp;
                u32x2 w; w.x = pk2(o.x, o.y); w.y = pk2(o.z, o.w); uo[64 * j] = w; }
        }
    }
}

struct SsmIn { const float *lam_re, *lam_im, *log_step, *b_re, *b_im, *c_re, *c_im; };
__device__ __forceinline__ void ssm_tables_item(const SsmIn si, int g, int dir, int jq, float* Ktab, bf16_t* Wst, bf16_t* B2, float* adec, LAS float* sc, int tid) {
    LAS float* apow = sc;
    LAS float* Bb = sc + 1152;
    LAS float* Cc = sc + 1152 + 2048;
    const int gd = g * 2 + dir;
    LAS float* qtab = sc + 1152 + 4096 + 128 * 65 * 2;
    float braw[2], biraw[2];
#pragma unroll
    for (int r = 0; r < 2; ++r) { const int idx = tid + 512 * r; braw[r] = si.b_re[g * 1024 + idx]; biraw[r] = si.b_im[g * 1024 + idx];
        Cc[idx * 2] = si.c_re[g * 1024 + idx]; Cc[idx * 2 + 1] = si.c_im[g * 1024 + idx]; }
    if (tid < 64) {
        const int p = tid; const float step = expf(si.log_step[g]);
        const float lr = si.lam_re[g * 64 + p], li = si.lam_im[g * 64 + p];
        float s1, c1, s0, c0;
        double th = (double)li * (double)step; const double th1 = th - 6.283185307179586 * floor(th * 0.15915494309189535);
        sincosf((float)th1, &s1, &c1);
        const float mag1 = expf(lr * step), a1r = mag1 * c1, a1i = mag1 * s1;
        th *= (double)(8 * jq); th -= 6.283185307179586 * floor(th * 0.15915494309189535);
        sincosf((float)th, &s0, &c0);
        const float mag0 = expf(lr * step * (float)(8 * jq)); float pr = mag0 * c0, pi = mag0 * s0;
#pragma unroll
        for (int jj = 0; jj < 9; ++jj) { apow[(jj * 64 + p) * 2] = pr; apow[(jj * 64 + p) * 2 + 1] = pi; const float nr = pr * a1r - pi * a1i, ni = pr * a1i + pi * a1r; pr = nr; pi = ni; }
        const float ar = a1r - 1.0f, ai = a1i, inv = 1.0f / (lr * lr + li * li);
        qtab[2 * p] = (ar * lr + ai * li) * inv; qtab[2 * p + 1] = (ai * lr - ar * li) * inv;
    }
    __syncthreads();
#pragma unroll
    for (int r = 0; r < 2; ++r) { const int idx = tid + 512 * r, p = idx >> 4; const float qr = qtab[2 * p], qi = qtab[2 * p + 1];
        Bb[idx * 2] = qr * braw[r] - qi * biraw[r]; Bb[idx * 2 + 1] = qr * biraw[r] + qi * braw[r]; }
    LAS float* ACs = sc + 1152 + 4096;
#pragma unroll 4
    for (int r = 0; r < 16; ++r) { const int idx = tid + 512 * r, p = idx & 63, jh = idx >> 6, jj = jh >> 4, h = jh & 15;
        const float ar = apow[(jj * 64 + p) * 2], ai = apow[(jj * 64 + p) * 2 + 1], cr = Cc[(h * 64 + p) * 2], ci = Cc[(h * 64 + p) * 2 + 1];
        *(LAS f32x2*)(ACs + (jh * 65 + p) * 2) = (f32x2){ar * cr - ai * ci, ar * ci + ai * cr}; }
    __syncthreads();
    { const int jh = tid >> 2, q = tid & 3;
      f32x4 o = {0.f, 0.f, 0.f, 0.f};
#pragma unroll 8
      for (int p = 0; p < 64; ++p) { const f32x2 ac = *(const LAS f32x2*)(ACs + (jh * 65 + p) * 2);
          const f32x4 b01 = *(const LAS f32x4*)(Bb + (p * 16 + 4 * q) * 2), b23 = *(const LAS f32x4*)(Bb + (p * 16 + 4 * q + 2) * 2);
          o.x += ac.x * b01.x - ac.y * b01.y; o.y += ac.x * b01.z - ac.y * b01.w; o.z += ac.x * b23.x - ac.y * b23.y; o.w += ac.x * b23.z - ac.y * b23.w; }
      *(f32x4*)(Ktab + ((size_t)(gd * 32 + 8 * jq + (jh >> 4)) * 16 + (jh & 15)) * 16 + 4 * q) = o; }
    { const int jj = tid >> 6, p = tid & 63, j = 8 * jq + jj, lp = dir == 0 ? 31 - j : j;
      const float ar = apow[(jj * 64 + p) * 2], ai = apow[(jj * 64 + p) * 2 + 1];
      unsigned wr[8], wi[8];
#pragma unroll
      for (int q = 0; q < 8; ++q) { const f32x4 b = *(const LAS f32x4*)(Bb + (p * 16 + 2 * q) * 2);
          wr[q] = pk2(ar * b.x - ai * b.y, ar * b.z - ai * b.w); wi[q] = pk2(ar * b.y + ai * b.x, ar * b.w + ai * b.z); }
      bf16_t* o = Wst + (size_t)(g * 256 + dir * 128 + 2 * p) * 512 + lp * 16;
      *(u32x4*)o = (u32x4){wr[0], wr[1], wr[2], wr[3]}; *(u32x4*)(o + 8) = (u32x4){wr[4], wr[5], wr[6], wr[7]};
      *(u32x4*)(o + 512) = (u32x4){wi[0], wi[1], wi[2], wi[3]}; *(u32x4*)(o + 520) = (u32x4){wi[4], wi[5], wi[6], wi[7]}; }
#pragma unroll
    for (int r = 0; r < 4; ++r) { const int idx = tid + 512 * r, pq = idx & 15, h = (idx >> 4) & 15, jj = idx >> 8, e = 8 * jq + jj + 1, l = dir == 0 ? e - 1 : 32 - e;
        const f32x4 a01 = *(const LAS f32x4*)(apow + ((jj + 1) * 64 + 4 * pq) * 2), a23 = *(const LAS f32x4*)(apow + ((jj + 1) * 64 + 4 * pq + 2) * 2);
        const f32x4 c01 = *(const LAS f32x4*)(Cc + (h * 64 + 4 * pq) * 2), c23 = *(const LAS f32x4*)(Cc + (h * 64 + 4 * pq + 2) * 2);
        u32x4 w;
        w.x = pk2(c01.x * a01.x - c01.y * a01.y, -(c01.x * a01.y + c01.y * a01.x)); w.y = pk2(c01.z * a01.z - c01.w * a01.w, -(c01.z * a01.w + c01.w * a01.z));
        w.z = pk2(c23.x * a23.x - c23.y * a23.y, -(c23.x * a23.y + c23.y * a23.x)); w.w = pk2(c23.z * a23.z - c23.w * a23.w, -(c23.z * a23.w + c23.w * a23.z));
        *(u32x4*)(B2 + (size_t)(g * 512 + l * 16 + h) * 768 + 512 + dir * 128 + 8 * pq) = w; }
    if (jq == 3 && tid < 64) { adec[(gd * 64 + tid) * 2] = apow[(8 * 64 + tid) * 2]; adec[(gd * 64 + tid) * 2 + 1] = apow[(8 * 64 + tid) * 2 + 1]; }
    __syncthreads();
}
__device__ __forceinline__ void toeplitz_items(const float* Ktab, const float* ssm_d, bf16_t* B2, int gt, int NGT) {
#pragma unroll 4
    for (int item = gt; item < 16384 * 64; item += NGT) {
        const int n = item >> 6, kc = (item & 63) * 8, lp = kc >> 4, hp0 = kc & 15, g = n >> 9, l = (n >> 4) & 31, h = n & 15;
        const int jf = l - lp > 0 ? l - lp : 0, jb = lp - l > 0 ? lp - l : 0;
        const float mf = lp <= l ? 1.f : 0.f, mb = lp >= l ? 1.f : 0.f;
        const f32x4* kf = (const f32x4*)(Ktab + ((size_t)((g * 2 + 0) * 32 + jf) * 16 + h) * 16 + hp0);
        const f32x4* kb = (const f32x4*)(Ktab + ((size_t)((g * 2 + 1) * 32 + jb) * 16 + h) * 16 + hp0);
        const f32x4 f0 = kf[0], f1 = kf[1], b0 = kb[0], b1 = kb[1];
        const float d = (lp == l && (h >> 3) == (hp0 >> 3)) ? ssm_d[g * 16 + h] : 0.f;
        f32x4 v0 = f0 * mf + b0 * mb, v1 = f1 * mf + b1 * mb;
        const int i = h & 7;
        v0.x += i == 0 ? d : 0.f; v0.y += i == 1 ? d : 0.f; v0.z += i == 2 ? d : 0.f; v0.w += i == 3 ? d : 0.f;
        v1.x += i == 4 ? d : 0.f; v1.y += i == 5 ? d : 0.f; v1.z += i == 6 ? d : 0.f; v1.w += i == 7 ? d : 0.f;
        u32x4 w; w.x = pk2(v0.x, v0.y); w.y = pk2(v0.z, v0.w); w.z = pk2(v1.x, v1.y); w.w = pk2(v1.z, v1.w);
        *(u32x4*)(B2 + (size_t)n * 768 + kc) = w;
    }
}
__device__ __forceinline__ void conv_tile(const bf16_t* GC, const float* cw, const float* cb, const float* lng, const float* lnb, const float* og, bf16_t* CAT, LAS float* sc, int tile, int tid, int lane, int wave) {
    const int t0 = tile * 32, half = tid >> 8, cp = tid & 255, c = 2 * cp;
    const int tb = t0 + half * 16, lseq = tb & (SEQ - 1);
    unsigned in[46];
#pragma unroll
    for (int i = 0; i < 46; ++i) { const int tt = lseq - 15 + i; in[i] = (tt >= 0 && tt < SEQ) ? *(const unsigned*)(GC + (size_t)(tb - 15 + i) * DC + c) : 0u; }
    float a0[16], a1[16];
    { const f32x2 b = *(const f32x2*)(cb + c);
#pragma unroll
      for (int o = 0; o < 16; ++o) { a0[o] = b.x; a1[o] = b.y; } }
#pragma unroll
    for (int k = 0; k < 31; ++k) { const f32x2 w = *(const f32x2*)(cw + k * DC + c);
#pragma unroll
        for (int o = 0; o < 16; ++o) { a0[o] += w.x * bf_lo(in[o + k]); a1[o] += w.y * bf_hi(in[o + k]); } }
#pragma unroll
    for (int o = 0; o < 16; ++o) *(LAS f32x2*)(sc + (half * 16 + o) * 512 + c) = (f32x2){a0[o], a1[o]};
    __syncthreads();
    const int c8 = 8 * lane;
    const f32x4 g0 = *(const f32x4*)(lng + c8), g1 = *(const f32x4*)(lng + c8 + 4), b0 = *(const f32x4*)(lnb + c8), b1 = *(const f32x4*)(lnb + c8 + 4);
    const f32x4 o0 = *(const f32x4*)(og + c8), o1 = *(const f32x4*)(og + c8 + 4);
#pragma unroll
    for (int q = 0; q < 4; ++q) { const int tok = 4 * wave + q;
        f32x4 x0 = *(const LAS f32x4*)(sc + tok * 512 + c8), x1 = *(const LAS f32x4*)(sc + tok * 512 + c8 + 4);
        const float mean = wave_sum((x0.x + x0.y) + (x0.z + x0.w) + (x1.x + x1.y) + (x1.z + x1.w)) * (1.0f / 512.0f);
        x0 = x0 - mean; x1 = x1 - mean;
        const float var = wave_sum((x0.x * x0.x + x0.y * x0.y) + (x0.z * x0.z + x0.w * x0.w) + (x1.x * x1.x + x1.y * x1.y) + (x1.z * x1.z + x1.w * x1.w)) * (1.0f / 512.0f);
        const float rstd = 1.0f / sqrtf(var + EPS);
        x0 = x0 * rstd * g0 + b0; x1 = x1 * rstd * g1 + b1;
        float y[8] = {silu_f(x0.x), silu_f(x0.y), silu_f(x0.z), silu_f(x0.w), silu_f(x1.x), silu_f(x1.y), silu_f(x1.z), silu_f(x1.w)};
        float ss = 0.f;
#pragma unroll
        for (int j = 0; j < 8; ++j) ss += y[j] * y[j];
        ss = sum8_dpp(ss);
        const float r = 1.0f / sqrtf(ss * (1.0f / 64.0f) + EPS);
        u32x4 w; w.x = pk2(y[0] * r * o0.x, y[1] * r * o0.y); w.y = pk2(y[2] * r * o0.z, y[3] * r * o0.w); w.z = pk2(y[4] * r * o1.x, y[5] * r * o1.y); w.w = pk2(y[6] * r * o1.z, y[7] * r * o1.w);
        *(u32x4*)(CAT + (size_t)(t0 + tok) * D + c8) = w; }
    __syncthreads();
}
__device__ __forceinline__ void scan_item(const float* X, const float* adec, bf16_t* A2, int item, int lane) {
    const int g = item >> 3, b = (item >> 1) & 3, dir = item & 1, p = lane;
    const f32x2 ad = *(const f32x2*)(adec + ((g * 2 + dir) * 64 + p) * 2);
    const int row0 = g * 512 + b * 128;
    const float* xp = X + (size_t)row0 * 256 + dir * 128 + 2 * p;
    bf16_t* sp = A2 + (size_t)row0 * 768 + 512 + dir * 128 + 2 * p;
    float sr = 0.f, si = 0.f;
    f32x2 xa[16], xb[16]; unsigned ob[16];
#define SCAN_LOAD(buf, cb) do { _Pragma("unroll") for (int i = 0; i < 16; ++i) { const int c = dir == 0 ? (cb) + i : 127 - ((cb) + i); buf[i] = *(const f32x2*)(xp + (size_t)c * 256); } } while (0)
#define SCAN_STEP(buf) do { _Pragma("unroll") for (int i = 0; i < 16; ++i) { ob[i] = pk2(sr, si); \
        const float nr = ad.x * sr - ad.y * si + buf[i].x, ni = ad.x * si + ad.y * sr + buf[i].y; sr = nr; si = ni; } } while (0)
#define SCAN_STORE(cb) do { _Pragma("unroll") for (int i = 0; i < 16; ++i) { const int c = dir == 0 ? (cb) + i : 127 - ((cb) + i); *(unsigned*)(sp + (size_t)c * 768) = ob[i]; } } while (0)
    SCAN_LOAD(xa, 0); SCAN_LOAD(xb, 16);
#pragma unroll 1
    for (int cb = 0; cb < 128; cb += 32) {
        SCAN_STEP(xa); if (cb + 32 < 128) SCAN_LOAD(xa, cb + 32); SCAN_STORE(cb);
        SCAN_STEP(xb); if (cb + 48 < 128) SCAN_LOAD(xb, cb + 48); SCAN_STORE(cb + 16);
    }
#undef SCAN_STORE
#undef SCAN_LOAD
#undef SCAN_STEP
}

struct Args { const float* in[40]; float* out; unsigned char* ws; int lo, hi; };

__global__ void __launch_bounds__(512, 2) hybrid_fwd(Args a) {
    extern __shared__ __attribute__((aligned(16))) unsigned char lds_raw[];
    LAS unsigned char* lds = (LAS unsigned char*)lds_raw;
    LAS float* ldsf = (LAS float*)lds_raw;
    cg::grid_group grid = cg::this_grid();
    const int tid = threadIdx.x, lane = tid & 63, wave = __builtin_amdgcn_readfirstlane(tid >> 6);
    const int G = gridDim.x, bid = blockIdx.x;
    const int gw = bid * 8 + wave, NGW = G * 8;
    const int lo = a.lo, hi = a.hi;
    unsigned char* ws = a.ws;
    bf16_t* Wgu1 = (bf16_t*)(ws + WS_WGU1); bf16_t* Wd1 = (bf16_t*)(ws + WS_WD1); bf16_t* Wgu2 = (bf16_t*)(ws + WS_WGU2); bf16_t* Wd2 = (bf16_t*)(ws + WS_WD2);
    bf16_t* Win = (bf16_t*)(ws + WS_WIN); bf16_t* Wglu = (bf16_t*)(ws + WS_WGLU); bf16_t* Wout = (bf16_t*)(ws + WS_WOUT);
    bf16_t* B2 = (bf16_t*)(ws + WS_B2); bf16_t* Wst = (bf16_t*)(ws + WS_WST); float* Ktab = (float*)(ws + WS_KTAB); float* adec = (float*)(ws + WS_ADEC);
    bf16_t* U = (bf16_t*)(ws + WS_U); bf16_t* F = (bf16_t*)(ws + WS_F); bf16_t* ACT = (bf16_t*)(ws + WS_ACT);
    bf16_t* GC = (bf16_t*)(ws + WS_GC); bf16_t* A2 = (bf16_t*)(ws + WS_A2); float* X = (float*)(ws + WS_X); bf16_t* YG = (bf16_t*)(ws + WS_YG);
    bf16_t* CAT = U;
    bf16_t* HB = (bf16_t*)(ws + WS_HB);
#define IN(k) (lo <= (k) && (k) < hi)
    volatile LAS unsigned* bst = (volatile LAS unsigned*)(lds + LDS_CTL);
    LAS TrDesc* desc = (LAS TrDesc*)(lds + LDS_CTL + 64);
    constexpr int I_G = (D / 64) * (DFF / 32), I_D = (DFF / 64) * (D / 32), I_IN = (D / 64) * (DIN / 32), I_GLU = (DS / 64) * (DS / 32), I_O = (D / 64) * (D / 32);
    constexpr int C0 = I_G, C1 = C0 + I_G, C2 = C1 + I_D, C3 = C2 + I_IN, C4 = C3 + I_G, C5 = C4 + I_G, C6 = C5 + I_D, C7 = C6 + I_GLU, C8 = C7 + I_O;
    if (tid == 0) { bst[0] = 0u; bst[1] = 0u;
        set_desc(desc + 0, a.in[2], (bf16_t*)(ws + WS_WGU1), D, DFF, 1, C0, a.in[1]);  set_desc(desc + 1, a.in[3], (bf16_t*)(ws + WS_WGU1), D, DFF, 2, C1, a.in[1]);  set_desc(desc + 2, a.in[4], (bf16_t*)(ws + WS_WD1), DFF, D, 0, C2);
        set_desc(desc + 3, a.in[7], (bf16_t*)(ws + WS_WIN), D, DIN, 3, C3, a.in[6]);
        set_desc(desc + 4, a.in[36], (bf16_t*)(ws + WS_WGU2), D, DFF, 1, C4, a.in[35]); set_desc(desc + 5, a.in[37], (bf16_t*)(ws + WS_WGU2), D, DFF, 2, C5, a.in[35]);
        set_desc(desc + 6, a.in[38], (bf16_t*)(ws + WS_WD2), DFF, D, 0, C6); set_desc(desc + 7, a.in[29], (bf16_t*)(ws + WS_WGLU), DS, DS, 4, C7); set_desc(desc + 8, a.in[32], (bf16_t*)(ws + WS_WOUT), D, D, 0, C8); }
    __syncthreads();
    XcdBarrier xbar; xbar.bar = (unsigned*)(ws + WS_BAR); xbar.x = 0; xbar.st = bst;
    if (hi - lo > 1) xbar = xcd_barrier_post((unsigned*)(ws + WS_BAR), bst);
#ifndef CG_SEAM
#define CG_SEAM 0
#endif
    if (hi > NPH) grid.sync();
#define SEAM(k) do { if (IN(k) && IN((k) + 1)) xcd_barrier(xbar); } while (0)

#define TAIL_VARS const bool tailwg = (G == 256) ? (bid >= 128) : true; const int tgw = (G == 256) ? (bid - 128) * 8 + wave : gw, TNGW = (G == 256) ? 128 * 8 : NGW; const int tb = (G == 256) ? bid - 128 : bid, TG = (G == 256) ? 128 : G; LAS float* scr = ldsf + wave * (64 * 33)
    if (IN(0)) {
#pragma unroll 1
        for (int pass = 0; pass < 3; ++pass) {
            if (pass == 1) {
                tr_range(desc, 0, 0, C1, gw, NGW, ldsf + wave * (64 * 33), lane);
                norm_rows(a.in[0], (float*)(ws + WS_SS) + 5 * T, U, gw, NGW, lane);
                __syncthreads();
            } else if ((pass == 0) == ((bid & 1) != 0)) {
                for (int it = bid; it < 256; it += G) {
                    const int gd = it >> 2, jq = it & 3, g = gd >> 1, dir = gd & 1;
                    const SsmIn si{dir ? a.in[21] : a.in[14], dir ? a.in[22] : a.in[15], dir ? a.in[23] : a.in[16], dir ? a.in[24] : a.in[17], dir ? a.in[25] : a.in[18], dir ? a.in[26] : a.in[19], dir ? a.in[27] : a.in[20]};
                    ssm_tables_item(si, g, dir, jq, Ktab, Wst, B2, adec, ldsf, tid);
                }
            }
        }
    }
    SEAM(0);
    if (IN(1)) {
        pg8::Gemm g{U, Wgu1, D, D, D}; pg8::Sched S; S.init(0, T, 2 * DFF, G, bid);
        const float* SSx = (const float*)(ws + WS_SS) + 5 * T;
        LAS float* rtab = (LAS float*)(lds + pg8::STAGE_BYTES);
        pg8::Unit u0; const int pm0 = S.next(0, u0) ? u0.pm : -1;
        if (pm0 >= 0 && tid < 256) rtab[tid] = __builtin_amdgcn_rsqf(SSx[pm0 * 256 + tid] * (1.0f / D) + EPS);
        __syncthreads();
        pg8::EpiSwiGLU E{ACT, DFF, SSx, rtab, pm0};
        pg8::gemm_phase(lds, g, S, E);
        TAIL_VARS;
        if (tailwg) tr_range(desc, 2, C1, C3, tgw, TNGW, scr, lane);
    }
    SEAM(1);
    float* SS = (float*)(ws + WS_SS);
    if (IN(2)) {
        pg8::Gemm g{ACT, Wd1, DFF, DFF, DFF}; pg8::Sched S; S.init(0, T, D, G, bid);
        pg8::EpiNormRes E{nullptr, U, 0.5f, a.in[5], nullptr, SS, SS + T, HB, nullptr, &xbar};
        pg8::gemm_phase(lds, g, S, E);
    }
    SEAM(2);
    if (IN(4)) {
        pg8::Gemm g{HB, Win, D, D, D}; pg8::Sched S; S.init(0, T, DIN, G, bid);
        LAS float* rtab = (LAS float*)(lds + pg8::STAGE_BYTES);
        pg8::Unit u0; const int pm0 = S.next(0, u0) ? u0.pm : -1;
        if (pm0 >= 0 && tid < 256) rtab[tid] = __builtin_amdgcn_rsqf(SS[T + pm0 * 256 + tid] * (1.0f / D) + EPS);
        LAS float* lbias = rtab + 256;
        for (int i = tid; i < DIN; i += 512) lbias[i] = a.in[8][i];
        __syncthreads();
        pg8::EpiWin E{GC, A2, lbias, SS + T, rtab, pm0};
        pg8::gemm_phase(lds, g, S, E);
        TAIL_VARS;
        if (tailwg) {
            tr_range(desc, 4, C3, C5, tgw, TNGW, scr, lane);
            toeplitz_items(Ktab, a.in[28], B2, tb * 512 + tid, TG * 512);
        }
    }
    SEAM(4);
    if (IN(5)) {
        if (bid < 64) {
            pg8::Gemm g{A2, Wst, 768, 512, 512}; pg8::Sched S; S.init(1, 0, 0, 64, bid);
            pg8::EpiXScan E{lds, adec, A2};
            pg8::gemm_phase(lds, g, S, E);
        } else {
            for (int tile = bid - 64; tile < 384; tile += G - 64) conv_tile(GC, a.in[9], a.in[10], a.in[11], a.in[12], a.in[13], CAT, ldsf, tile, tid, lane, wave);
        }
    }
    SEAM(6);
    if (IN(7)) {
        pg8::Gemm g{A2, B2, 768, 768, 768}; pg8::Sched S; S.init(2, 0, 0, G, bid);
        pg8::EpiS2 E{YG};
        pg8::gemm_phase(lds, g, S, E);
        TAIL_VARS;
        if (G == 256 && bid >= 128) conv_tile(GC, a.in[9], a.in[10], a.in[11], a.in[12], a.in[13], CAT, ldsf, 384 + bid - 128, tid, lane, wave);
        if (tailwg) tr_range(desc, 6, C5, C8, tgw, TNGW, scr, lane);
    }
    SEAM(7);
    if (IN(8)) {
        pg8::Gemm g{YG, Wglu, DS, DS, DS}; pg8::Sched S; S.init(0, T, DS, G, bid);
        pg8::EpiGlu E{YG, CAT, a.in[30], a.in[31]};
        pg8::gemm_phase(lds, g, S, E);
    }
    SEAM(8);
    if (IN(9)) {
        pg8::Gemm g{CAT, Wout, D, D, D}; pg8::Sched S; S.init(0, T, D, G, bid);
        pg8::EpiNormRes E{nullptr, HB, 1.0f, a.in[34], a.in[33], SS + 2 * T, SS + 3 * T, HB, nullptr, &xbar};
        pg8::gemm_phase(lds, g, S, E);
    }
    SEAM(9);
    if (IN(11)) {
        pg8::Gemm g{HB, Wgu2, D, D, D}; pg8::Sched S; S.init(0, T, 2 * DFF, G, bid);
        LAS float* rtab = (LAS float*)(lds + pg8::STAGE_BYTES);
        pg8::Unit u0; const int pm0 = S.next(0, u0) ? u0.pm : -1;
        if (pm0 >= 0 && tid < 256) rtab[tid] = __builtin_amdgcn_rsqf(SS[3 * T + pm0 * 256 + tid] * (1.0f / D) + EPS);
        __syncthreads();
        pg8::EpiSwiGLU E{ACT, DFF, SS + 3 * T, rtab, pm0};
        pg8::gemm_phase(lds, g, S, E);
    }
    SEAM(11);
    if (IN(12)) {
        pg8::Gemm g{ACT, Wd2, DFF, DFF, DFF}; pg8::Sched S; S.init(0, T, D, G, bid);
        pg8::EpiNormRes E{nullptr, HB, 0.5f, a.in[39], nullptr, SS + 4 * T, nullptr, nullptr, a.out, &xbar};
        pg8::gemm_phase(lds, g, S, E);
    }
#undef IN
#undef SEAM
}

extern "C" void kernel_launch(void* const* d_in, const int* in_sizes, int n_in, void* d_out, int out_size, void* d_ws, size_t ws_size, hipStream_t stream) {
    constexpr int LDS_BYTES = LDS_CTL + 512;
    static int grid = 0;
    if (grid == 0) {
        int dev = 0, cus = 0, per_cu = 0;
        if (n_in != 40 || ws_size < WS_END) { fprintf(stderr, "kernel_launch: unexpected n_in %d / ws_size %zu (need %zu)\n", n_in, ws_size, (size_t)WS_END); grid = -1; return; }
        hipGetDevice(&dev);
        hipDeviceGetAttribute(&cus, hipDeviceAttributeMultiprocessorCount, dev);
        if (hipFuncSetAttribute((const void*)hybrid_fwd, hipFuncAttributeMaxDynamicSharedMemorySize, LDS_BYTES) != hipSuccess) { fprintf(stderr, "kernel_launch: hipFuncSetAttribute failed\n"); grid = -1; return; }
        if (hipOccupancyMaxActiveBlocksPerMultiprocessor(&per_cu, (const void*)hybrid_fwd, 512, LDS_BYTES) != hipSuccess || per_cu < 1) { fprintf(stderr, "kernel_launch: occupancy query failed (%d)\n", per_cu); (void)hipGetLastError(); per_cu = 1; }
        if (cus != 256) { fprintf(stderr, "kernel_launch: built for a 256-CU device (one 256x256 unit per workgroup in the fused-norm GEMM phases); got %d CUs\n", cus); grid = -1; return; }
        grid = cus * 1;
        if (grid <= 0) grid = 256;
    }
    if (grid < 0) return;
    if (hipMemsetAsync((unsigned char*)d_ws + WS_BAR, 0, ZERO_BYTES, stream) != hipSuccess) { fprintf(stderr, "kernel_launch: hipMemsetAsync failed\n"); return; }
    Args a{};
    for (int i = 0; i < 40; ++i) a.in[i] = (const float*)d_in[i];
    a.out = (float*)d_out; a.ws = (unsigned char*)d_ws;
    a.lo = 0; a.hi = NPH;
    void* args[] = {&a};
    hipError_t e = hipLaunchCooperativeKernel((const void*)hybrid_fwd, dim3(grid), dim3(512), args, LDS_BYTES, stream);
    if (e != hipSuccess) fprintf(stderr, "kernel_launch: cooperative launch failed: %s (grid %d)\n", hipGetErrorString(e), grid);
}
```

```cpp
#include <hip/hip_runtime.h>
#include <hip/hip_cooperative_groups.h>
#include <cstdio>
namespace cg = cooperative_groups;


#define LAS __attribute__((address_space(3)))
typedef unsigned short bf16_t;
typedef short bf16x8 __attribute__((ext_vector_type(8)));
typedef float f32x4 __attribute__((ext_vector_type(4)));
typedef float f32x2 __attribute__((ext_vector_type(2)));
typedef unsigned u32x4 __attribute__((ext_vector_type(4)));
typedef unsigned u32x2 __attribute__((ext_vector_type(2)));

constexpr int T = 16384, D = 1024, DFF = 2816, DIN = 1536, DC = 512, DS = 512, SEQ = 4096;
constexpr int NPH = 14;
constexpr int LDS_CTL = 136 * 1024;
constexpr float EPS = 1e-6f;

constexpr size_t SZ_WGU = (size_t)2 * DFF * D * 2, SZ_WD = (size_t)D * DFF * 2;
constexpr size_t WS_WGU1 = 0, WS_WD1 = WS_WGU1 + SZ_WGU, WS_WGU2 = WS_WGU1, WS_WD2 = WS_WD1;
constexpr size_t WS_HB = WS_WD1 + SZ_WD;
constexpr size_t WS_WIN = WS_HB + (size_t)T * D * 2, WS_WGLU = WS_WIN + (size_t)DIN * D * 2, WS_WOUT = WS_WGLU + (size_t)DS * DS * 2;
constexpr size_t WS_B2 = WS_WOUT + (size_t)D * D * 2;
constexpr size_t WS_WST = WS_B2 + (size_t)16384 * 768 * 2;
constexpr size_t WS_KTAB = WS_WST + (size_t)8192 * 512 * 2;
constexpr size_t WS_ADEC = WS_KTAB + (size_t)64 * 32 * 256 * 4;
constexpr size_t WS_U = WS_ADEC + (size_t)64 * 64 * 2 * 4;
constexpr size_t WS_F = WS_U + (size_t)T * D * 2;
constexpr size_t WS_ACT = WS_F + (size_t)T * D * 2;
constexpr size_t WS_GC = WS_ACT;
constexpr size_t WS_A2 = WS_GC + (size_t)T * DC * 2;
constexpr size_t WS_X = WS_A2 + (size_t)16384 * 768 * 2;
constexpr size_t WS_YG = WS_X + (size_t)16384 * 256 * 4;
constexpr size_t WS_BAR = WS_ACT + (size_t)T * DFF * 2;
constexpr size_t WS_SS = WS_BAR + 16384;
constexpr size_t WS_END = WS_SS + (size_t)6 * T * 4;
constexpr size_t ZERO_BYTES = WS_END - WS_BAR;
static_assert(WS_YG + (size_t)T * DS * 2 <= WS_BAR, "mixer aliases fit");
static_assert(WS_END <= (size_t)256 * 1024 * 1024, "workspace");

__device__ __forceinline__ unsigned pk2(float lo, float hi) { unsigned r; asm volatile("v_cvt_pk_bf16_f32 %0, %1, %2" : "=v"(r) : "v"(lo), "v"(hi)); return r; }
__device__ __forceinline__ float bf_lo(unsigned v) { return __uint_as_float(v << 16); }
__device__ __forceinline__ float bf_hi(unsigned v) { return __uint_as_float(v & 0xffff0000u); }
__device__ __forceinline__ float sigmoid_f(float x) { return __builtin_amdgcn_rcpf(1.0f + __builtin_amdgcn_exp2f(-1.4426950408889634f * x)); }
__device__ __forceinline__ float silu_f(float x) { return x * sigmoid_f(x); }
__device__ __forceinline__ float gelu_tanh_f(float x) { return x * sigmoid_f(1.5957691216057308f * (x + 0.044715f * x * x * x)); }
template <int CTRL> __device__ __forceinline__ float dpp_f(float v) { return __builtin_bit_cast(float, __builtin_amdgcn_update_dpp(0, __builtin_bit_cast(int, v), CTRL, 0xF, 0xF, true)); }
__device__ __forceinline__ float sum8_dpp(float v) {
    v += dpp_f<0xB1>(v);
    v += dpp_f<0x4E>(v);
    v += dpp_f<0x141>(v);
    return v;
}
__device__ __forceinline__ float wave_sum(float v) {
    v = sum8_dpp(v);
    v += dpp_f<0x140>(v);
    const int iv = __builtin_bit_cast(int, v);
    const float r0 = __builtin_bit_cast(float, __builtin_amdgcn_readlane(iv, 0)), r1 = __builtin_bit_cast(float, __builtin_amdgcn_readlane(iv, 16));
    const float r2 = __builtin_bit_cast(float, __builtin_amdgcn_readlane(iv, 32)), r3 = __builtin_bit_cast(float, __builtin_amdgcn_readlane(iv, 48));
    return (r0 + r1) + (r2 + r3);
}

#define XB_TMO      128
#define XB_XCNT(j)  (256  + 64 * (j))
#define XB_XSUB(j)  (1280 + 64 * (j))
#define XB_XGEN(j)  (2304 + 64 * (j))
#define XB_TOP      3328
#define XB_TOPGEN   3392
#define XCD_BAR_WORDS 3456
#define XB_SPIN_CAP (1u << 18)
__device__ __forceinline__ unsigned xb_ld(unsigned* p)              { return __hip_atomic_load(p, __ATOMIC_RELAXED, __HIP_MEMORY_SCOPE_AGENT); }
__device__ __forceinline__ unsigned xb_add(unsigned* p, unsigned v) { return __hip_atomic_fetch_add(p, v, __ATOMIC_RELAXED, __HIP_MEMORY_SCOPE_AGENT); }
__device__ __forceinline__ unsigned xb_xcc_id() { return (unsigned)__builtin_amdgcn_s_getreg((3 << 11) | 20) & 0xFu; }
#define XB_SPIN(cond, bar) do { unsigned _sp = 0; while (cond) { __builtin_amdgcn_s_sleep(1); \
    if ((++_sp & 255u) == 0u) { if (xb_ld(&(bar)[XB_TMO])) break; if (_sp > XB_SPIN_CAP) { atomicAdd(&(bar)[XB_TMO], 1u); break; } } } } while (0)
struct XcdBarrier { unsigned* bar; unsigned x; volatile LAS unsigned* st; };
__device__ __forceinline__ XcdBarrier xcd_barrier_post(unsigned* bar, volatile LAS unsigned* st) {
    XcdBarrier b; b.bar = bar; b.x = xb_xcc_id(); b.st = st;
    if (threadIdx.x == 0) (void)xb_add(&bar[XB_XCNT(b.x)], 1u);
    return b;
}
__device__ __forceinline__ void xcd_barrier_complete(unsigned* bar, unsigned x, unsigned& nloc, unsigned& nx) {
    const unsigned G = gridDim.x * gridDim.y * gridDim.z;
    unsigned sum, cnt, mine, sp = 0u;
    for (;;) {
        sum = 0u; cnt = 0u; mine = 0u;
#pragma unroll
        for (unsigned j = 0; j < 16; ++j) { const unsigned c = xb_ld(&bar[XB_XCNT(j)]); sum += c; cnt += (c > 0u) ? 1u : 0u; mine = (j == x) ? c : mine; }
        if (sum == G) break;
        __builtin_amdgcn_s_sleep(1);
        if ((++sp & 255u) == 0u) { if (xb_ld(&bar[XB_TMO])) break; if (sp > XB_SPIN_CAP) { atomicAdd(&bar[XB_TMO], 1u); break; } }
    }
    nloc = mine > 0u ? mine : 1u; nx = cnt > 0u ? cnt : 1u;
}
__device__ __forceinline__ void xcd_barrier(const XcdBarrier& b) {
    asm volatile("s_waitcnt vmcnt(0)" ::: "memory");
    __syncthreads();
    if (threadIdx.x == 0) {
        unsigned* bar = b.bar;
        __builtin_amdgcn_s_waitcnt(0);
        unsigned nloc = b.st[0], nx = b.st[1];
        if (nloc == 0u) { xcd_barrier_complete(bar, b.x, nloc, nx); b.st[0] = nloc; b.st[1] = nx; }
        const unsigned old = xb_add(&bar[XB_XSUB(b.x)], 1u);
        const unsigned gen = old / nloc;
        if (old + 1u == (gen + 1u) * nloc) {
            __builtin_amdgcn_fence(__ATOMIC_RELEASE, "agent");
            asm volatile("s_waitcnt vmcnt(0)" ::: "memory");
            const unsigned og = xb_add(&bar[XB_TOP], 1u);
            const unsigned tg = og / nx;
            if (og + 1u == (tg + 1u) * nx) xb_add(&bar[XB_TOPGEN], 1u);
            else XB_SPIN(xb_ld(&bar[XB_TOPGEN]) == tg, bar);
            __builtin_amdgcn_fence(__ATOMIC_ACQUIRE, "agent");
            xb_add(&bar[XB_XGEN(b.x)], 1u);
            asm volatile("s_waitcnt vmcnt(0)" ::: "memory");
        } else {
            XB_SPIN(xb_ld(&bar[XB_XGEN(b.x)]) == gen, bar);
            __builtin_amdgcn_fence(__ATOMIC_ACQUIRE, "agent");
            asm volatile("s_waitcnt vmcnt(0)" ::: "memory");
        }
    }
    __syncthreads();
}

namespace pg8 {
constexpr int BM = 256, BK = 64, HALF = 128, HTB = HALF * BK * 2, STAGE_BYTES = 8 * HTB, NXCD = 8, WGM = 8;
__host__ __device__ __forceinline__ int lds_byte(int r, int c) { const int st = (r >> 4) * 2 + (c >> 5), rr = r & 15, cc = c & 31, ob = rr * 64 + cc * 2; return st * 1024 + (ob ^ (((ob >> 9) & 1) << 5)); }
__host__ __device__ __forceinline__ void stage_rc(int b, int& R, int& C) { const int st = b / 1024, sb = b % 1024, swz = sb ^ (((sb >> 9) & 1) << 5); R = (st >> 1) * 16 + swz / 64; C = (st & 1) * 32 + (swz % 64) / 2; }
__host__ __device__ __forceinline__ int perm32(int rho) { const int n = rho >> 4, i = rho & 15; return 8 * (i >> 2) + 4 * n + (i & 3); }

struct Unit { int pm, pn, pb; };
struct Gemm { const bf16_t* A; const bf16_t* Bt; int lda, ldb, K; };

struct Sched {
    int mode, nM, nN, nwg, G, c;
    __device__ __forceinline__ void init(int mode_, int M, int N, int G_, int c_) { mode = mode_; nM = M / BM; nN = N / BM; nwg = nM * nN; G = G_; c = c_; }
    __device__ __forceinline__ bool next(int i, Unit& u) const {
        const long L = (long)i * G + c;
        if (mode == 1) { if (L >= 64) return false; u.pm = (int)L; u.pn = 0; u.pb = (int)L >> 1; return true; }
        if (mode == 2) { if (L >= 128) return false; u.pm = (int)L >> 1; u.pn = (int)L & 1; u.pb = (u.pm >> 1) * 2 + u.pn; return true; }
        if (L >= nwg) return false;
        int wgid = (int)L; { const int q = nwg / NXCD, r = nwg % NXCD, xcd = wgid % NXCD, off = wgid / NXCD; wgid = (xcd < r ? xcd * (q + 1) : r * (q + 1) + (xcd - r) * q) + off; }
        const int nig = WGM * nN, gid = wgid / nig, fm = gid * WGM, gsz = (nM - fm) < WGM ? (nM - fm) : WGM;
        u.pm = fm + ((wgid % nig) % gsz); u.pn = (wgid % nig) / gsz; u.pb = u.pn; return true;
    }
};

typedef f32x4 Acc[2][2][4][2];

template <class Epi>
__device__ __forceinline__ void gemm_phase(LAS unsigned char* lds, const Gemm g, const Sched& S, const Epi& E) {
    const int tid = threadIdx.x, wid = __builtin_amdgcn_readfirstlane(tid >> 6), lane = tid & 63, wr = wid >> 2, wc = wid & 3, fr = lane & 15, fq = lane >> 4;
    const int K = g.K, nt = K / BK;
    unsigned voffA[2], voffB[2];
#pragma unroll
    for (int i = 0; i < 2; ++i) { int R, C; stage_rc(tid * 16 + i * 8192, R, C); const int Rb = Epi::PERM ? ((R & ~31) + perm32(R & 31)) : R;
        voffA[i] = (unsigned)(R * g.lda + C) * 2u; voffB[i] = (unsigned)(Rb * g.ldb + C) * 2u; }
    const size_t kstep = (size_t)(BK * 2);
    const size_t hstepA = (size_t)HALF * g.lda * 2, hstepB = (size_t)HALF * g.ldb * 2;
    const size_t tstepA = 2 * hstepA, tstepB = 2 * hstepB;
    const unsigned ldsw = (unsigned)wid * 1024u;
    const int aoff = lds_byte(wr * 64 + fr, fq * 8), boff = lds_byte(wc * 32 + fr, fq * 8);
#define PG8_SA(b, h) (((b) * 2 + (h)) * HTB)
#define PG8_SB(b, h) ((4 + (b) * 2 + (h)) * HTB)
#define PG8_STAGE(bufoff, gbase, voff) do { _Pragma("unroll") for (int _i = 0; _i < 2; ++_i) \
        __builtin_amdgcn_global_load_lds((const unsigned*)((const char*)(gbase) + (voff)[_i]), (LAS unsigned*)(lds + (bufoff) + ldsw + _i * 8192), 16, 0, 0); } while (0)
#define PG8_LDA(dst, b, h) do { _Pragma("unroll") for (int m = 0; m < 4; ++m) _Pragma("unroll") for (int k = 0; k < 2; ++k) dst[m][k] = *(const LAS bf16x8*)(lds + PG8_SA(b, h) + aoff + m * 2048 + k * 1024); } while (0)
#define PG8_LDB(dst, b, h) do { _Pragma("unroll") for (int n = 0; n < 2; ++n) _Pragma("unroll") for (int k = 0; k < 2; ++k) dst[n][k] = *(const LAS bf16x8*)(lds + PG8_SB(b, h) + boff + n * 2048 + k * 1024); } while (0)
#define PG8_MMA(ai, bj, At, Bt) do { __builtin_amdgcn_s_setprio(1); _Pragma("unroll") for (int m = 0; m < 4; ++m) _Pragma("unroll") for (int n = 0; n < 2; ++n) _Pragma("unroll") for (int k = 0; k < 2; ++k) \
        acc[ai][bj][m][n] = __builtin_amdgcn_mfma_f32_16x16x32_bf16(Bt[n][k], At[m][k], acc[ai][bj][m][n], 0, 0, 0); __builtin_amdgcn_s_setprio(0); } while (0)
#define PG8_WAIT_V(n) asm volatile("s_waitcnt vmcnt(" #n ")" ::: "memory")
#define PG8_WAIT_L(n) asm volatile("s_waitcnt lgkmcnt(" #n ")" ::: "memory")
#define PG8_BAR __builtin_amdgcn_s_barrier()
#define PG8_SCHED __builtin_amdgcn_sched_barrier(0)
    Unit cur, nxt; int ui = 0;
    if (!S.next(0, cur)) return;
    Acc acc;
#pragma unroll
    for (int a = 0; a < 2; ++a)
#pragma unroll
        for (int b = 0; b < 2; ++b)
#pragma unroll
            for (int m = 0; m < 4; ++m)
#pragma unroll
                for (int n = 0; n < 2; ++n) acc[a][b][m][n] = (f32x4){0.f, 0.f, 0.f, 0.f};
    bf16x8 At[4][2], B0[2][2], B1[2][2];
    const char* cA = (const char*)g.A + (size_t)cur.pm * tstepA; const char* cB = (const char*)g.Bt + (size_t)cur.pb * tstepB;
    PG8_STAGE(PG8_SB(0, 0), cB, voffB); PG8_STAGE(PG8_SA(0, 0), cA, voffA); PG8_STAGE(PG8_SB(0, 1), cB + hstepB, voffB); PG8_STAGE(PG8_SA(0, 1), cA + hstepA, voffA);
    if (wr == 1) PG8_BAR;
    PG8_WAIT_V(4); PG8_BAR;
    PG8_STAGE(PG8_SB(1, 0), cB + kstep, voffB); PG8_STAGE(PG8_SA(1, 0), cA + kstep, voffA); PG8_STAGE(PG8_SB(1, 1), cB + hstepB + kstep, voffB);
    PG8_WAIT_V(6); PG8_BAR;
    for (;;) {
        const bool has_next = S.next(ui + 1, nxt);
        const char* nA = has_next ? (const char*)g.A + (size_t)nxt.pm * tstepA : cA; const char* nB = has_next ? (const char*)g.Bt + (size_t)nxt.pb * tstepB : cB;
        for (int t = 0; t < nt; t += 2) {
            const bool last = (t == nt - 2);
            const char* a1 = cA + (size_t)(t + 1) * kstep;
            const char* a2 = last ? nA : cA + (size_t)(t + 2) * kstep; const char* b2 = last ? nB : cB + (size_t)(t + 2) * kstep;
            const char* a3 = a2 + kstep; const char* b3 = b2 + kstep;
            PG8_LDB(B0, 0, 0); PG8_SCHED; PG8_LDA(At, 0, 0); PG8_STAGE(PG8_SA(1, 1), a1 + hstepA, voffA);
            PG8_WAIT_L(8); PG8_BAR; PG8_WAIT_L(0); PG8_MMA(0, 0, At, B0); PG8_BAR; PG8_SCHED;
            PG8_LDB(B1, 0, 1); PG8_STAGE(PG8_SB(0, 0), b2, voffB);
            PG8_BAR; PG8_WAIT_L(0); PG8_MMA(0, 1, At, B1); PG8_BAR;
            PG8_LDA(At, 0, 1); PG8_STAGE(PG8_SA(0, 0), a2, voffA);
            PG8_BAR; PG8_WAIT_L(0); PG8_MMA(1, 0, At, B0); PG8_BAR; PG8_SCHED;
            PG8_STAGE(PG8_SB(0, 1), b2 + hstepB, voffB);
            PG8_WAIT_V(6); PG8_BAR; PG8_MMA(1, 1, At, B1); PG8_BAR;
            PG8_LDB(B0, 1, 0); PG8_SCHED; PG8_LDA(At, 1, 0); PG8_STAGE(PG8_SA(0, 1), a2 + hstepA, voffA);
            PG8_WAIT_L(8); PG8_BAR; PG8_WAIT_L(0); PG8_MMA(0, 0, At, B0); PG8_BAR; PG8_SCHED;
            PG8_LDB(B1, 1, 1); PG8_STAGE(PG8_SB(1, 0), b3, voffB);
            PG8_BAR; PG8_WAIT_L(0); PG8_MMA(0, 1, At, B1); PG8_BAR;
            PG8_LDA(At, 1, 1); PG8_STAGE(PG8_SA(1, 0), a3, voffA);
            PG8_BAR; PG8_WAIT_L(0); PG8_MMA(1, 0, At, B0); PG8_BAR; PG8_SCHED;
            PG8_STAGE(PG8_SB(1, 1), b3 + hstepB, voffB);
            PG8_WAIT_V(6); PG8_BAR; PG8_MMA(1, 1, At, B1); PG8_BAR;
        }
        if constexpr (!Epi::AFTER_DRAIN) E(acc, cur, wr, wc, fr, fq);
        if (!has_next) break;
#pragma unroll
        for (int a = 0; a < 2; ++a)
#pragma unroll
            for (int b = 0; b < 2; ++b)
#pragma unroll
                for (int m = 0; m < 4; ++m)
#pragma unroll
                    for (int n = 0; n < 2; ++n) acc[a][b][m][n] = (f32x4){0.f, 0.f, 0.f, 0.f};
        cur = nxt; cA = nA; cB = nB; ++ui;
    }
    PG8_WAIT_V(0);
    if (wr == 0) PG8_BAR;
    PG8_BAR;
    if constexpr (Epi::AFTER_DRAIN) E.fused(acc, cur, wr, wc, fr, fq);
#undef PG8_SA
#undef PG8_SB
#undef PG8_STAGE
#undef PG8_LDA
#undef PG8_LDB
#undef PG8_MMA
#undef PG8_WAIT_V
#undef PG8_WAIT_L
#undef PG8_BAR
#undef PG8_SCHED
}

struct EpiBf16 {
    static constexpr bool PERM = true, AFTER_DRAIN = false;
    bf16_t* O; int ldc; const float* bias;
    __device__ __forceinline__ void operator()(const Acc& acc, const Unit& u, int wr, int wc, int fr, int fq) const {
        const int row0 = u.pm * BM + wr * 64 + fr, col0 = u.pn * BM + wc * 32 + 8 * fq;
        f32x4 bv[2][2];
#pragma unroll
        for (int bj = 0; bj < 2; ++bj)
#pragma unroll
            for (int n = 0; n < 2; ++n) bv[bj][n] = bias ? *(const f32x4*)(bias + col0 + bj * HALF + 4 * n) : (f32x4){0.f, 0.f, 0.f, 0.f};
#pragma unroll
        for (int ai = 0; ai < 2; ++ai)
#pragma unroll
            for (int m = 0; m < 4; ++m) { bf16_t* rowp = O + (size_t)(row0 + ai * HALF + m * 16) * ldc + col0;
#pragma unroll
                for (int bj = 0; bj < 2; ++bj) { const f32x4 v0 = acc[ai][bj][m][0] + bv[bj][0], v1 = acc[ai][bj][m][1] + bv[bj][1];
                    u32x4 w; w.x = pk2(v0[0], v0[1]); w.y = pk2(v0[2], v0[3]); w.z = pk2(v1[0], v1[1]); w.w = pk2(v1[2], v1[3]);
                    *(u32x4*)(rowp + bj * HALF) = w; } }
    }
};
struct EpiF32 {
    static constexpr bool PERM = false, AFTER_DRAIN = false;
    float* C; int ldc;
    __device__ __forceinline__ void operator()(const Acc& acc, const Unit& u, int wr, int wc, int fr, int fq) const {
        const int row0 = u.pm * BM + wr * 64 + fr, col0 = u.pn * BM + wc * 32 + 4 * fq;
#pragma unroll
        for (int ai = 0; ai < 2; ++ai)
#pragma unroll
            for (int m = 0; m < 4; ++m) { float* rowp = C + (size_t)(row0 + ai * HALF + m * 16) * ldc + col0;
#pragma unroll
                for (int bj = 0; bj < 2; ++bj)
#pragma unroll
                    for (int n = 0; n < 2; ++n) *(f32x4*)(rowp + bj * HALF + n * 16) = acc[ai][bj][m][n]; }
    }
};
struct EpiXScan {
    static constexpr bool PERM = false, AFTER_DRAIN = true;
    LAS unsigned char* lds; const float* adec; bf16_t* A2;
    __device__ __forceinline__ void operator()(const Acc&, const Unit&, int, int, int, int) const {}
    __device__ __forceinline__ void fused(Acc& acc, const Unit& u, int wr, int wc, int fr, int fq) const {
        constexpr int PITCH = 520;
#pragma unroll
        for (int ai = 0; ai < 2; ++ai)
#pragma unroll
            for (int m = 0; m < 4; ++m) { const int r = ai * HALF + wr * 64 + m * 16 + fr;
#pragma unroll
                for (int bj = 0; bj < 2; ++bj)
#pragma unroll
                    for (int n = 0; n < 2; ++n) { const int c = bj * HALF + wc * 32 + n * 16 + 4 * fq; const f32x4 v = acc[ai][bj][m][n];
                        u32x2 w; w.x = pk2(v[0], v[1]); w.y = pk2(v[2], v[3]); *(LAS u32x2*)(lds + r * PITCH + c * 2) = w; } }
        __syncthreads();
        const int wave = threadIdx.x >> 6, lane = threadIdx.x & 63;
        if (wave < 4) {
            const int bsel = wave >> 1, dir = wave & 1, g = u.pm >> 1, b = 2 * (u.pm & 1) + bsel;
            const f32x2 ad = *(const f32x2*)(adec + ((g * 2 + dir) * 64 + lane) * 2);
            bf16_t* sp = A2 + (size_t)(g * 512 + b * 128) * 768 + 512 + dir * 128 + 2 * lane;
            const LAS unsigned char* xp = lds + (128 * bsel) * PITCH + (dir * 128 + 2 * lane) * 2;
            float sr = 0.f, si = 0.f;
#pragma unroll 16
            for (int k = 0; k < 128; ++k) { const int c = dir == 0 ? k : 127 - k;
                const unsigned xv = *(const LAS unsigned*)(xp + c * PITCH);
                *(unsigned*)(sp + (size_t)c * 768) = pk2(sr, si);
                const float nr = ad.x * sr - ad.y * si + bf_lo(xv), ni = ad.x * si + ad.y * sr + bf_hi(xv); sr = nr; si = ni; }
        }
    }
};
struct EpiSwiGLU {
    static constexpr bool PERM = true, AFTER_DRAIN = false;
    bf16_t* O; int ldc; const float* rowss; const LAS float* rtab; int pm0;
    __device__ __forceinline__ void operator()(const Acc& acc, const Unit& u, int wr, int wc, int fr, int fq) const {
        const int row0 = u.pm * BM + wr * 64 + fr, col0 = u.pn * HALF + wc * 32 + 8 * fq;
#pragma unroll
        for (int ai = 0; ai < 2; ++ai)
#pragma unroll
            for (int m = 0; m < 4; ++m) { const int row = row0 + ai * HALF + m * 16; bf16_t* rowp = O + (size_t)row * ldc + col0;
                const float r = !rowss ? 1.0f : (u.pm == pm0 ? rtab[row - pm0 * BM] : __builtin_amdgcn_rsqf(rowss[row] * (1.0f / D) + EPS));
                float v[8];
#pragma unroll
                for (int n = 0; n < 2; ++n)
#pragma unroll
                    for (int j = 0; j < 4; ++j) v[4 * n + j] = silu_f(acc[ai][0][m][n][j] * r) * (acc[ai][1][m][n][j] * r);
                u32x4 w; w.x = pk2(v[0], v[1]); w.y = pk2(v[2], v[3]); w.z = pk2(v[4], v[5]); w.w = pk2(v[6], v[7]);
                *(u32x4*)rowp = w; }
    }
};
struct EpiNormRes {
    static constexpr bool PERM = true, AFTER_DRAIN = true;
    const float* res_f32; const bf16_t* res_bf16; float alpha; const float* gpost; const float* bias; float* ss1; float* ss2; bf16_t* hb; float* out; const XcdBarrier* bar;
    __device__ __forceinline__ void operator()(const Acc&, const Unit&, int, int, int, int) const {}
    __device__ __forceinline__ void fused(Acc& acc, const Unit& u, int wr, int wc, int fr, int fq) const {
        const int row0 = u.pm * BM + wr * 64 + fr, col0 = u.pn * BM + wc * 32 + 8 * fq;
        if (bias) {
#pragma unroll
            for (int bj = 0; bj < 2; ++bj)
#pragma unroll
                for (int n = 0; n < 2; ++n) { const f32x4 bv = *(const f32x4*)(bias + col0 + bj * HALF + 4 * n);
#pragma unroll
                    for (int ai = 0; ai < 2; ++ai)
#pragma unroll
                        for (int m = 0; m < 4; ++m) acc[ai][bj][m][n] += bv; }
        }
#pragma unroll
        for (int ai = 0; ai < 2; ++ai)
#pragma unroll
            for (int m = 0; m < 4; ++m) { float q = 0.f;
#pragma unroll
                for (int bj = 0; bj < 2; ++bj)
#pragma unroll
                    for (int n = 0; n < 2; ++n) { const f32x4 x = acc[ai][bj][m][n]; q += (x[0] * x[0] + x[1] * x[1]) + (x[2] * x[2] + x[3] * x[3]); }
                q += __shfl_xor(q, 16); q += __shfl_xor(q, 32);
                if (fq == 0) __hip_atomic_fetch_add(ss1 + row0 + ai * HALF + m * 16, q, __ATOMIC_RELAXED, __HIP_MEMORY_SCOPE_AGENT); }
        u32x4 rpre[2][4][2];
        if (res_bf16) {
#pragma unroll
            for (int ai = 0; ai < 2; ++ai)
#pragma unroll
                for (int m = 0; m < 4; ++m)
#pragma unroll
                    for (int bj = 0; bj < 2; ++bj) rpre[ai][m][bj] = *(const u32x4*)(res_bf16 + (size_t)(row0 + ai * HALF + m * 16) * D + col0 + bj * HALF);
        }
        xcd_barrier(*bar);
        float rs[2][4];
#pragma unroll
        for (int ai = 0; ai < 2; ++ai)
#pragma unroll
            for (int m = 0; m < 4; ++m) rs[ai][m] = ss1[row0 + ai * HALF + m * 16];
        f32x4 gp[2][2];
#pragma unroll
        for (int bj = 0; bj < 2; ++bj)
#pragma unroll
            for (int n = 0; n < 2; ++n) gp[bj][n] = *(const f32x4*)(gpost + col0 + bj * HALF + 4 * n);
#pragma unroll
        for (int ai = 0; ai < 2; ++ai)
#pragma unroll
            for (int m = 0; m < 4; ++m) { const int row = row0 + ai * HALF + m * 16;
                const float r = alpha * __builtin_amdgcn_rsqf(rs[ai][m] * (1.0f / D) + EPS);
                float q = 0.f;
#pragma unroll
                for (int bj = 0; bj < 2; ++bj) { const size_t off = (size_t)row * D + col0 + bj * HALF;
                    f32x4 r0, r1;
                    if (res_bf16) { const u32x4 t = rpre[ai][m][bj]; r0 = (f32x4){bf_lo(t.x), bf_hi(t.x), bf_lo(t.y), bf_hi(t.y)}; r1 = (f32x4){bf_lo(t.z), bf_hi(t.z), bf_lo(t.w), bf_hi(t.w)}; }
                    else { r0 = *(const f32x4*)(res_f32 + off); r1 = *(const f32x4*)(res_f32 + off + 4); }
                    const f32x4 h0 = r0 + acc[ai][bj][m][0] * r * gp[bj][0], h1 = r1 + acc[ai][bj][m][1] * r * gp[bj][1];
                    q += (h0[0] * h0[0] + h0[1] * h0[1]) + (h0[2] * h0[2] + h0[3] * h0[3]) + (h1[0] * h1[0] + h1[1] * h1[1]) + (h1[2] * h1[2] + h1[3] * h1[3]);
                    if (hb) { u32x4 w; w.x = pk2(h0[0], h0[1]); w.y = pk2(h0[2], h0[3]); w.z = pk2(h1[0], h1[1]); w.w = pk2(h1[2], h1[3]); *(u32x4*)(hb + off) = w; }
                    else { *(f32x4*)(out + off) = h0; *(f32x4*)(out + off + 4) = h1; } }
                if (ss2) { q += __shfl_xor(q, 16); q += __shfl_xor(q, 32);
                    if (fq == 0) __hip_atomic_fetch_add(ss2 + row, q, __ATOMIC_RELAXED, __HIP_MEMORY_SCOPE_AGENT); } }
    }
};
struct EpiWin {
    static constexpr bool PERM = true, AFTER_DRAIN = false;
    bf16_t* GC; bf16_t* A2; const LAS float* bias; const float* rowss; const LAS float* rtab; int pm0;
    __device__ __forceinline__ void operator()(const Acc& acc, const Unit& u, int wr, int wc, int fr, int fq) const {
        const int row0 = u.pm * BM + wr * 64 + fr;
        if (u.pn < 4) {
            const int col0 = u.pn * HALF + wc * 32 + 8 * fq;
            f32x4 bvv[2], bvg[2];
#pragma unroll
            for (int n = 0; n < 2; ++n) { bvv[n] = *(const LAS f32x4*)(bias + col0 + 4 * n); bvg[n] = *(const LAS f32x4*)(bias + 512 + col0 + 4 * n); }
#pragma unroll
            for (int ai = 0; ai < 2; ++ai)
#pragma unroll
                for (int m = 0; m < 4; ++m) { const int row = row0 + ai * HALF + m * 16; bf16_t* rowp = GC + (size_t)row * DC + col0;
                    const float r = u.pm == pm0 ? rtab[row - pm0 * BM] : __builtin_amdgcn_rsqf(rowss[row] * (1.0f / D) + EPS);
                    float v[8];
#pragma unroll
                    for (int n = 0; n < 2; ++n)
#pragma unroll
                        for (int j = 0; j < 4; ++j) v[4 * n + j] = (acc[ai][0][m][n][j] * r + bvv[n][j]) * sigmoid_f(acc[ai][1][m][n][j] * r + bvg[n][j]);
                    u32x4 w; w.x = pk2(v[0], v[1]); w.y = pk2(v[2], v[3]); w.z = pk2(v[4], v[5]); w.w = pk2(v[6], v[7]);
                    *(u32x4*)rowp = w; }
        } else {
#pragma unroll
            for (int bj = 0; bj < 2; ++bj) {
                const int s = (u.pn - 4) * BM + bj * HALF + wc * 32 + 8 * fq;
                const int gg = s >> 4, h0 = s & 15;
                const f32x4 b0 = *(const LAS f32x4*)(bias + 1024 + s), b1 = *(const LAS f32x4*)(bias + 1024 + s + 4);
#pragma unroll
                for (int ai = 0; ai < 2; ++ai)
#pragma unroll
                    for (int m = 0; m < 4; ++m) { const int t = row0 + ai * HALF + m * 16;
                        const float r = u.pm == pm0 ? rtab[t - pm0 * BM] : __builtin_amdgcn_rsqf(rowss[t] * (1.0f / D) + EPS);
                        const f32x4 v0 = acc[ai][bj][m][0] * r + b0, v1 = acc[ai][bj][m][1] * r + b1;
                        u32x4 w; w.x = pk2(v0[0], v0[1]); w.y = pk2(v0[2], v0[3]); w.z = pk2(v1[0], v1[1]); w.w = pk2(v1[2], v1[3]);
                        *(u32x4*)(A2 + ((size_t)(gg * 512 + (t >> 5)) * 768 + (t & 31) * 16 + h0)) = w; }
            }
        }
    }
};
struct EpiS2 {
    static constexpr bool PERM = true, AFTER_DRAIN = false;
    bf16_t* YG;
    __device__ __forceinline__ void operator()(const Acc& acc, const Unit& u, int wr, int wc, int fr, int fq) const {
        const int row0 = u.pm * BM + wr * 64 + fr;
#pragma unroll
        for (int bj = 0; bj < 2; ++bj) {
            const int col = u.pn * BM + bj * HALF + wc * 32 + 8 * fq, l = col >> 4, h0 = col & 15;
#pragma unroll
            for (int ai = 0; ai < 2; ++ai)
#pragma unroll
                for (int m = 0; m < 4; ++m) { const int row = row0 + ai * HALF + m * 16, gg = row >> 9, chunk = row & 511;
                    float v[8];
#pragma unroll
                    for (int n = 0; n < 2; ++n)
#pragma unroll
                        for (int j = 0; j < 4; ++j) v[4 * n + j] = gelu_tanh_f(acc[ai][bj][m][n][j]);
                    u32x4 w; w.x = pk2(v[0], v[1]); w.y = pk2(v[2], v[3]); w.z = pk2(v[4], v[5]); w.w = pk2(v[6], v[7]);
                    *(u32x4*)(YG + ((size_t)(chunk * 32 + l) * DS + gg * 16 + h0)) = w; }
        }
    }
};
struct EpiGlu {
    static constexpr bool PERM = true, AFTER_DRAIN = false;
    const bf16_t* YG; bf16_t* CAT; const float* bias; const float* og;
    __device__ __forceinline__ void operator()(const Acc& acc, const Unit& u, int wr, int wc, int fr, int fq) const {
        const int row0 = u.pm * BM + wr * 64 + fr, hl = u.pn * BM + wc * 64 + 8 * fq;
        f32x4 bz[2][2], gz[2][2];
#pragma unroll
        for (int bj = 0; bj < 2; ++bj)
#pragma unroll
            for (int n = 0; n < 2; ++n) { bz[bj][n] = *(const f32x4*)(bias + hl + 32 * bj + 4 * n); gz[bj][n] = *(const f32x4*)(og + hl + 32 * bj + 4 * n); }
#pragma unroll
        for (int ai = 0; ai < 2; ++ai) {
        u32x4 ypre[4][2];
#pragma unroll
        for (int m = 0; m < 4; ++m)
#pragma unroll
            for (int bj = 0; bj < 2; ++bj) ypre[m][bj] = *(const u32x4*)(YG + (size_t)(row0 + ai * HALF + m * 16) * DS + hl + 32 * bj);
#pragma unroll
            for (int m = 0; m < 4; ++m) { const int row = row0 + ai * HALF + m * 16;
                float v[2][8]; float ss = 0.f;
#pragma unroll
                for (int bj = 0; bj < 2; ++bj) { const u32x4 yv = ypre[m][bj];
                    const float y[8] = {bf_lo(yv.x), bf_hi(yv.x), bf_lo(yv.y), bf_hi(yv.y), bf_lo(yv.z), bf_hi(yv.z), bf_lo(yv.w), bf_hi(yv.w)};
#pragma unroll
                    for (int n = 0; n < 2; ++n)
#pragma unroll
                        for (int j = 0; j < 4; ++j) { const float z = acc[ai][bj][m][n][j] + bz[bj][n][j]; const float o = y[4 * n + j] * sigmoid_f(z); v[bj][4 * n + j] = o; ss += o * o; } }
                ss += __shfl_xor(ss, 16); ss += __shfl_xor(ss, 32);
                const float r = __builtin_amdgcn_rsqf(ss * (1.0f / 64.0f) + EPS);
#pragma unroll
                for (int bj = 0; bj < 2; ++bj) { u32x4 w;
                    w.x = pk2(v[bj][0] * r * gz[bj][0][0], v[bj][1] * r * gz[bj][0][1]); w.y = pk2(v[bj][2] * r * gz[bj][0][2], v[bj][3] * r * gz[bj][0][3]);
                    w.z = pk2(v[bj][4] * r * gz[bj][1][0], v[bj][5] * r * gz[bj][1][1]); w.w = pk2(v[bj][6] * r * gz[bj][1][2], v[bj][7] * r * gz[bj][1][3]);
                    *(u32x4*)(CAT + (size_t)row * D + 512 + hl + 32 * bj) = w; } }
        }
    }
};
}

__device__ __forceinline__ void tr_item(const float* W, int K, int N, bf16_t* WT, int k0, int n0, int drow0, const float* rg, LAS float* scr, int lane) {
    { const int kr = lane >> 3, n4 = lane & 7; f32x4 v[8];
#pragma unroll
      for (int i = 0; i < 8; ++i) v[i] = *(const f32x4*)(W + (size_t)(k0 + kr + 8 * i) * N + n0 + 4 * n4);
#pragma unroll
      for (int i = 0; i < 8; ++i) { const float gk = rg ? rg[k0 + kr + 8 * i] : 1.0f;
          LAS float* d = scr + (kr + 8 * i) * 33 + 4 * n4; d[0] = v[i].x * gk; d[1] = v[i].y * gk; d[2] = v[i].z * gk; d[3] = v[i].w * gk; } }
    asm volatile("s_waitcnt lgkmcnt(0)" ::: "memory");
    const int c = lane & 7;
#pragma unroll
    for (int j = 0; j < 4; ++j) { const int n = (lane >> 3) + 8 * j; const LAS float* s = scr + (8 * c) * 33 + n;
        u32x4 o; o.x = pk2(s[0 * 33], s[1 * 33]); o.y = pk2(s[2 * 33], s[3 * 33]); o.z = pk2(s[4 * 33], s[5 * 33]); o.w = pk2(s[6 * 33], s[7 * 33]);
        *(u32x4*)(WT + (size_t)(drow0 + n) * K + k0 + 8 * c) = o; }
    asm volatile("s_waitcnt lgkmcnt(0)" ::: "memory");
}
__device__ __forceinline__ int drow_of(int mode, int n0) {
    if (mode == 1) return 256 * (n0 >> 7) + (n0 & 127);
    if (mode == 2) return 256 * (n0 >> 7) + 128 + (n0 & 127);
    if (mode == 3) { if (n0 < 512) return 256 * (n0 >> 7) + (n0 & 127); if (n0 < 1024) { const int n1 = n0 - 512; return 256 * (n1 >> 7) + 128 + (n1 & 127); } return n0; }
    if (mode == 4) { const int pn = n0 >> 8, r = n0 & 255, wc = r >> 6, bj = (r & 63) >> 5; return 256 * pn + 128 * bj + 32 * wc; }
    return n0;
}
__device__ __forceinline__ void tr_matrix_item(const float* W, int K, int N, bf16_t* WT, int mode, const float* rg, int item, LAS float* scr, int lane) {
    const int nblk = N / 32, kb = item / nblk, nb = item % nblk;
    tr_item(W, K, N, WT, 64 * kb, 32 * nb, drow_of(mode, 32 * nb), rg, scr, lane);
}

struct TrDesc { const float* W; bf16_t* WT; const float* rg; int K, N, mode, end; };
__device__ __forceinline__ void set_desc(LAS TrDesc* d, const float* W, bf16_t* WT, int K, int N, int mode, int end, const float* rg = nullptr) { d->W = W; d->WT = WT; d->rg = rg; d->K = K; d->N = N; d->mode = mode; d->end = end; }
__device__ __forceinline__ void tr_range(const LAS TrDesc* desc, int kfirst, int item_lo, int item_hi, int w0, int wstride, LAS float* scr, int lane) {
    for (int it = item_lo + w0; it < item_hi; it += wstride) {
        int k = kfirst; while (it >= desc[k].end) ++k;
        k = __builtin_amdgcn_readfirstlane(k);
        const int base = k ? desc[k - 1].end : 0;
        const unsigned long long wq = (unsigned long long)desc[k].W, tq = (unsigned long long)desc[k].WT, gq = (unsigned long long)desc[k].rg;
        const float* rg = (const float*)(((unsigned long long)(unsigned)__builtin_amdgcn_readfirstlane((int)(gq >> 32)) << 32) | (unsigned)__builtin_amdgcn_readfirstlane((int)gq));
        const float* W = (const float*)(((unsigned long long)(unsigned)__builtin_amdgcn_readfirstlane((int)(wq >> 32)) << 32) | (unsigned)__builtin_amdgcn_readfirstlane((int)wq));
        bf16_t* WT = (bf16_t*)(((unsigned long long)(unsigned)__builtin_amdgcn_readfirstlane((int)(tq >> 32)) << 32) | (unsigned)__builtin_amdgcn_readfirstlane((int)tq));
        const int K = __builtin_amdgcn_readfirstlane(desc[k].K), N = __builtin_amdgcn_readfirstlane(desc[k].N), mode = __builtin_amdgcn_readfirstlane(desc[k].mode);
        tr_matrix_item(W, K, N, WT, mode, rg, it - __builtin_amdgcn_readfirstlane(base), scr, lane);
    }
}

__device__ __forceinline__ void norm_rows(const float* x, float* ssx, bf16_t* uout, int gw, int NGW, int lane) {
    for (int m = gw; m < T; m += 2 * NGW) {
        const int m2 = m + NGW; const bool has2 = m2 < T; const int mm2 = has2 ? m2 : m;
        const f32x4* r1 = (const f32x4*)(x + (size_t)m * D) + lane; const f32x4* r2 = (const f32x4*)(x + (size_t)mm2 * D) + lane;
        f32x4 h1[4], h2[4]; float s1 = 0.f, s2 = 0.f;
#pragma unroll
        for (int j = 0; j < 4; ++j) { h1[j] = r1[64 * j]; h2[j] = r2[64 * j]; }
        u32x2* u1 = (u32x2*)(uout + (size_t)m * D) + lane; u32x2* u2 = (u32x2*)(uout + (size_t)mm2 * D) + lane;
#pragma unroll
        for (int j = 0; j < 4; ++j) { u32x2 w; w.x = pk2(h1[j].x, h1[j].y); w.y = pk2(h1[j].z, h1[j].w); u1[64 * j] = w;
            if (has2) { u32x2 v; v.x = pk2(h2[j].x, h2[j].y); v.y = pk2(h2[j].z, h2[j].w); u2[64 * j] = v; } }
#pragma unroll
        for (int j = 0; j < 4; ++j) { s1 += (h1[j].x * h1[j].x + h1[j].y * h1[j].y) + (h1[j].z * h1[j].z + h1[j].w * h1[j].w); s2 += (h2[j].x * h2[j].x + h2[j].y * h2[j].y) + (h2[j].z * h2[j].z + h2[j].w * h2[j].w); }
#pragma unroll
        for (int o = 1; o < 64; o <<= 1) { s1 += __shfl_xor(s1, o); s2 += __shfl_xor(s2, o); }
        if (lane == 0) { ssx[m] = s1; if (has2) ssx[m2] = s2; }
    }
}
template <bool RES_BF16, bool OUT_BF16, bool WRITE_U>
__device__ __forceinline__ void row_pass(const void* res, const bf16_t* f, const float* gpost, float alpha, void* hout, const float* gpre, bf16_t* uout, int gw, int NGW, int lane) {
    for (int m = gw; m < T; m += NGW) {
        f32x4 h[4];
        if (RES_BF16) { const u32x2* rr = (const u32x2*)((const bf16_t*)res + (size_t)m * D) + lane;
#pragma unroll
            for (int j = 0; j < 4; ++j) { const u32x2 q = rr[64 * j]; h[j] = (f32x4){bf_lo(q.x), bf_hi(q.x), bf_lo(q.y), bf_hi(q.y)}; } }
        else { const f32x4* rr = (const f32x4*)((const float*)res + (size_t)m * D) + lane;
#pragma unroll
            for (int j = 0; j < 4; ++j) h[j] = rr[64 * j]; }
        const u32x2* fr2 = (const u32x2*)(f + (size_t)m * D) + lane;
        f32x4 fv[4]; float ss = 0.f;
#pragma unroll
        for (int j = 0; j < 4; ++j) { const u32x2 q = fr2[64 * j]; fv[j] = (f32x4){bf_lo(q.x), bf_hi(q.x), bf_lo(q.y), bf_hi(q.y)};
            ss += (fv[j].x * fv[j].x + fv[j].y * fv[j].y) + (fv[j].z * fv[j].z + fv[j].w * fv[j].w); }
        const float rstd = alpha / sqrtf(wave_sum(ss) * (1.0f / D) + EPS);
#pragma unroll
        for (int j = 0; j < 4; ++j) { const f32x4 gp = ((const f32x4*)gpost)[lane + 64 * j]; h[j] = h[j] + fv[j] * rstd * gp; }
        if (OUT_BF16) { u32x2* ho = (u32x2*)((bf16_t*)hout + (size_t)m * D) + lane;
#pragma unroll
            for (int j = 0; j < 4; ++j) { u32x2 w; w.x = pk2(h[j].x, h[j].y); w.y = pk2(h[j].z, h[j].w); ho[64 * j] = w; } }
        else { f32x4* ho = (f32x4*)((float*)hout + (size_t)m * D) + lane;
#pragma unroll
            for (int j = 0; j < 4; ++j) ho[64 * j] = h[j]; }
        if (WRITE_U) {
            float s2 = 0.f;
#pragma unroll
            for (int j = 0; j < 4; ++j) s2 += (h[j].x * h[j].x + h[j].y * h[j].y) + (h[j].z * h[j].z + h[j].w * h[j].w);
            const float r2 = 1.0f / sqrtf(wave_sum(s2) * (1.0f / D) + EPS);
            u32x2* uo = (u32x2*)(uout + (size_t)m * D) + lane;
#pragma unroll
            for (int j = 0; j < 4; ++j) { const f32x4 gp = ((const f32x4*)gpre)[lane + 64 * j]; const f32x4 o = h[j] * r2 * gp;
                u32x2 w; w.x = pk2(o.x, o.y); w.y = pk2(o.z, o.w); uo[64 * j] = w; }
        }
    }
}

struct SsmIn { const float *lam_re, *lam_im, *log_step, *b_re, *b_im, *c_re, *c_im; };
__device__ __forceinline__ void ssm_tables_item(const SsmIn si, int g, int dir, int jq, float* Ktab, bf16_t* Wst, bf16_t* B2, float* adec, LAS float* sc, int tid) {
    LAS float* apow = sc;
    LAS float* Bb = sc + 1152;
    LAS float* Cc = sc + 1152 + 2048;
    const int gd = g * 2 + dir;
    LAS float* qtab = sc + 1152 + 4096 + 128 * 65 * 2;
    float braw[2], biraw[2];
#pragma unroll
    for (int r = 0; r < 2; ++r) { const int idx = tid + 512 * r; braw[r] = si.b_re[g * 1024 + idx]; biraw[r] = si.b_im[g * 1024 + idx];
        Cc[idx * 2] = si.c_re[g * 1024 + idx]; Cc[idx * 2 + 1] = si.c_im[g * 1024 + idx]; }
    if (tid < 64) {
        const int p = tid; const float step = expf(si.log_step[g]);
        const float lr = si.lam_re[g * 64 + p], li = si.lam_im[g * 64 + p];
        float s1, c1, s0, c0;
        double th = (double)li * (double)step; const double th1 = th - 6.283185307179586 * floor(th * 0.15915494309189535);
        sincosf((float)th1, &s1, &c1);
        const float mag1 = expf(lr * step), a1r = mag1 * c1, a1i = mag1 * s1;
        th *= (double)(8 * jq); th -= 6.283185307179586 * floor(th * 0.15915494309189535);
        sincosf((float)th, &s0, &c0);
        const float mag0 = expf(lr * step * (float)(8 * jq)); float pr = mag0 * c0, pi = mag0 * s0;
#pragma unroll
        for (int jj = 0; jj < 9; ++jj) { apow[(jj * 64 + p) * 2] = pr; apow[(jj * 64 + p) * 2 + 1] = pi; const float nr = pr * a1r - pi * a1i, ni = pr * a1i + pi * a1r; pr = nr; pi = ni; }
        const float ar = a1r - 1.0f, ai = a1i, inv = 1.0f / (lr * lr + li * li);
        qtab[2 * p] = (ar * lr + ai * li) * inv; qtab[2 * p + 1] = (ai * lr - ar * li) * inv;
    }
    __syncthreads();
#pragma unroll
    for (int r = 0; r < 2; ++r) { const int idx = tid + 512 * r, p = idx >> 4; const float qr = qtab[2 * p], qi = qtab[2 * p + 1];
        Bb[idx * 2] = qr * braw[r] - qi * biraw[r]; Bb[idx * 2 + 1] = qr * biraw[r] + qi * braw[r]; }
    LAS float* ACs = sc + 1152 + 4096;
#pragma unroll 4
    for (int r = 0; r < 16; ++r) { const int idx = tid + 512 * r, p = idx & 63, jh = idx >> 6, jj = jh >> 4, h = jh & 15;
        const float ar = apow[(jj * 64 + p) * 2], ai = apow[(jj * 64 + p) * 2 + 1], cr = Cc[(h * 64 + p) * 2], ci = Cc[(h * 64 + p) * 2 + 1];
        *(LAS f32x2*)(ACs + (jh * 65 + p) * 2) = (f32x2){ar * cr - ai * ci, ar * ci + ai * cr}; }
    __syncthreads();
    { const int jh = tid >> 2, q = tid & 3;
      f32x4 o = {0.f, 0.f, 0.f, 0.f};
#pragma unroll 8
      for (int p = 0; p < 64; ++p) { const f32x2 ac = *(const LAS f32x2*)(ACs + (jh * 65 + p) * 2);
          const f32x4 b01 = *(const LAS f32x4*)(Bb + (p * 16 + 4 * q) * 2), b23 = *(const LAS f32x4*)(Bb + (p * 16 + 4 * q + 2) * 2);
          o.x += ac.x * b01.x - ac.y * b01.y; o.y += ac.x * b01.z - ac.y * b01.w; o.z += ac.x * b23.x - ac.y * b23.y; o.w += ac.x * b23.z - ac.y * b23.w; }
      *(f32x4*)(Ktab + ((size_t)(gd * 32 + 8 * jq + (jh >> 4)) * 16 + (jh & 15)) * 16 + 4 * q) = o; }
    { const int jj = tid >> 6, p = tid & 63, j = 8 * jq + jj, lp = dir == 0 ? 31 - j : j;
      const float ar = apow[(jj * 64 + p) * 2], ai = apow[(jj * 64 + p) * 2 + 1];
      unsigned wr[8], wi[8];
#pragma unroll
      for (int q = 0; q < 8; ++q) { const f32x4 b = *(const LAS f32x4*)(Bb + (p * 16 + 2 * q) * 2);
          wr[q] = pk2(ar * b.x - ai * b.y, ar * b.z - ai * b.w); wi[q] = pk2(ar * b.y + ai * b.x, ar * b.w + ai * b.z); }
      bf16_t* o = Wst + (size_t)(g * 256 + dir * 128 + 2 * p) * 512 + lp * 16;
      *(u32x4*)o = (u32x4){wr[0], wr[1], wr[2], wr[3]}; *(u32x4*)(o + 8) = (u32x4){wr[4], wr[5], wr[6], wr[7]};
      *(u32x4*)(o + 512) = (u32x4){wi[0], wi[1], wi[2], wi[3]}; *(u32x4*)(o + 520) = (u32x4){wi[4], wi[5], wi[6], wi[7]}; }
#pragma unroll
    for (int r = 0; r < 4; ++r) { const int idx = tid + 512 * r, pq = idx & 15, h = (idx >> 4) & 15, jj = idx >> 8, e = 8 * jq + jj + 1, l = dir == 0 ? e - 1 : 32 - e;
        const f32x4 a01 = *(const LAS f32x4*)(apow + ((jj + 1) * 64 + 4 * pq) * 2), a23 = *(const LAS f32x4*)(apow + ((jj + 1) * 64 + 4 * pq + 2) * 2);
        const f32x4 c01 = *(const LAS f32x4*)(Cc + (h * 64 + 4 * pq) * 2), c23 = *(const LAS f32x4*)(Cc + (h * 64 + 4 * pq + 2) * 2);
        u32x4 w;
        w.x = pk2(c01.x * a01.x - c01.y * a01.y, -(c01.x * a01.y + c01.y * a01.x)); w.y = pk2(c01.z * a01.z - c01.w * a01.w, -(c01.z * a01.w + c01.w * a01.z));
        w.z = pk2(c23.x * a23.x - c23.y * a23.y, -(c23.x * a23.y + c23.y * a23.x)); w.w = pk2(c23.z * a23.z - c23.w * a23.w, -(c23.z * a23.w + c23.w * a23.z));
        *(u32x4*)(B2 + (size_t)(g * 512 + l * 16 + h) * 768 + 512 + dir * 128 + 8 * pq) = w; }
    if (jq == 3 && tid < 64) { adec[(gd * 64 + tid) * 2] = apow[(8 * 64 + tid) * 2]; adec[(gd * 64 + tid) * 2 + 1] = apow[(8 * 64 + tid) * 2 + 1]; }
    __syncthreads();
}
__device__ __forceinline__ void toeplitz_items(const float* Ktab, const float* ssm_d, bf16_t* B2, int gt, int NGT) {
#pragma unroll 4
    for (int item = gt; item < 16384 * 64; item += NGT) {
        const int n = item >> 6, kc = (item & 63) * 8, lp = kc >> 4, hp0 = kc & 15, g = n >> 9, l = (n >> 4) & 31, h = n & 15;
        const int jf = l - lp > 0 ? l - lp : 0, jb = lp - l > 0 ? lp - l : 0;
        const float mf = lp <= l ? 1.f : 0.f, mb = lp >= l ? 1.f : 0.f;
        const f32x4* kf = (const f32x4*)(Ktab + ((size_t)((g * 2 + 0) * 32 + jf) * 16 + h) * 16 + hp0);
        const f32x4* kb = (const f32x4*)(Ktab + ((size_t)((g * 2 + 1) * 32 + jb) * 16 + h) * 16 + hp0);
        const f32x4 f0 = kf[0], f1 = kf[1], b0 = kb[0], b1 = kb[1];
        const float d = (lp == l && (h >> 3) == (hp0 >> 3)) ? ssm_d[g * 16 + h] : 0.f;
        f32x4 v0 = f0 * mf + b0 * mb, v1 = f1 * mf + b1 * mb;
        const int i = h & 7;
        v0.x += i == 0 ? d : 0.f; v0.y += i == 1 ? d : 0.f; v0.z += i == 2 ? d : 0.f; v0.w += i == 3 ? d : 0.f;
        v1.x += i == 4 ? d : 0.f; v1.y += i == 5 ? d : 0.f; v1.z += i == 6 ? d : 0.f; v1.w += i == 7 ? d : 0.f;
        u32x4 w; w.x = pk2(v0.x, v0.y); w.y = pk2(v0.z, v0.w); w.z = pk2(v1.x, v1.y); w.w = pk2(v1.z, v1.w);
        *(u32x4*)(B2 + (size_t)n * 768 + kc) = w;
    }
}
__device__ __forceinline__ void conv_tile(const bf16_t* GC, const float* cw, const float* cb, const float* lng, const float* lnb, const float* og, bf16_t* CAT, LAS float* sc, int tile, int tid, int lane, int wave) {
    const int t0 = tile * 32, half = tid >> 8, cp = tid & 255, c = 2 * cp;
    const int tb = t0 + half * 16, lseq = tb & (SEQ - 1);
    unsigned in[46];
#pragma unroll
    for (int i = 0; i < 46; ++i) { const int tt = lseq - 15 + i; in[i] = (tt >= 0 && tt < SEQ) ? *(const unsigned*)(GC + (size_t)(tb - 15 + i) * DC + c) : 0u; }
    float a0[16], a1[16];
    { const f32x2 b = *(const f32x2*)(cb + c);
#pragma unroll
      for (int o = 0; o < 16; ++o) { a0[o] = b.x; a1[o] = b.y; } }
#pragma unroll
    for (int k = 0; k < 31; ++k) { const f32x2 w = *(const f32x2*)(cw + k * DC + c);
#pragma unroll
        for (int o = 0; o < 16; ++o) { a0[o] += w.x * bf_lo(in[o + k]); a1[o] += w.y * bf_hi(in[o + k]); } }
#pragma unroll
    for (int o = 0; o < 16; ++o) *(LAS f32x2*)(sc + (half * 16 + o) * 512 + c) = (f32x2){a0[o], a1[o]};
    __syncthreads();
    const int c8 = 8 * lane;
    const f32x4 g0 = *(const f32x4*)(lng + c8), g1 = *(const f32x4*)(lng + c8 + 4), b0 = *(const f32x4*)(lnb + c8), b1 = *(const f32x4*)(lnb + c8 + 4);
    const f32x4 o0 = *(const f32x4*)(og + c8), o1 = *(const f32x4*)(og + c8 + 4);
#pragma unroll
    for (int q = 0; q < 4; ++q) { const int tok = 4 * wave + q;
        f32x4 x0 = *(const LAS f32x4*)(sc + tok * 512 + c8), x1 = *(const LAS f32x4*)(sc + tok * 512 + c8 + 4);
        const float mean = wave_sum((x0.x + x0.y) + (x0.z + x0.w) + (x1.x + x1.y) + (x1.z + x1.w)) * (1.0f / 512.0f);
        x0 = x0 - mean; x1 = x1 - mean;
        const float var = wave_sum((x0.x * x0.x + x0.y * x0.y) + (x0.z * x0.z + x0.w * x0.w) + (x1.x * x1.x + x1.y * x1.y) + (x1.z * x1.z + x1.w * x1.w)) * (1.0f / 512.0f);
        const float rstd = 1.0f / sqrtf(var + EPS);
        x0 = x0 * rstd * g0 + b0; x1 = x1 * rstd * g1 + b1;
        float y[8] = {silu_f(x0.x), silu_f(x0.y), silu_f(x0.z), silu_f(x0.w), silu_f(x1.x), silu_f(x1.y), silu_f(x1.z), silu_f(x1.w)};
        float ss = 0.f;
#pragma unroll
        for (int j = 0; j < 8; ++j) ss += y[j] * y[j];
        ss = sum8_dpp(ss);
        const float r = 1.0f / sqrtf(ss * (1.0f / 64.0f) + EPS);
        u32x4 w; w.x = pk2(y[0] * r * o0.x, y[1] * r * o0.y); w.y = pk2(y[2] * r * o0.z, y[3] * r * o0.w); w.z = pk2(y[4] * r * o1.x, y[5] * r * o1.y); w.w = pk2(y[6] * r * o1.z, y[7] * r * o1.w);
        *(u32x4*)(CAT + (size_t)(t0 + tok) * D + c8) = w; }
    __syncthreads();
}
__device__ __forceinline__ void scan_item(const float* X, const float* adec, bf16_t* A2, int item, int lane) {
    const int g = item >> 3, b = (item >> 1) & 3, dir = item & 1, p = lane;
    const f32x2 ad = *(const f32x2*)(adec + ((g * 2 + dir) * 64 + p) * 2);
    const int row0 = g * 512 + b * 128;
    const float* xp = X + (size_t)row0 * 256 + dir * 128 + 2 * p;
    bf16_t* sp = A2 + (size_t)row0 * 768 + 512 + dir * 128 + 2 * p;
    float sr = 0.f, si = 0.f;
    f32x2 xa[16], xb[16]; unsigned ob[16];
#define SCAN_LOAD(buf, cb) do { _Pragma("unroll") for (int i = 0; i < 16; ++i) { const int c = dir == 0 ? (cb) + i : 127 - ((cb) + i); buf[i] = *(const f32x2*)(xp + (size_t)c * 256); } } while (0)
#define SCAN_STEP(buf) do { _Pragma("unroll") for (int i = 0; i < 16; ++i) { ob[i] = pk2(sr, si); \
        const float nr = ad.x * sr - ad.y * si + buf[i].x, ni = ad.x * si + ad.y * sr + buf[i].y; sr = nr; si = ni; } } while (0)
#define SCAN_STORE(cb) do { _Pragma("unroll") for (int i = 0; i < 16; ++i) { const int c = dir == 0 ? (cb) + i : 127 - ((cb) + i); *(unsigned*)(sp + (size_t)c * 768) = ob[i]; } } while (0)
    SCAN_LOAD(xa, 0); SCAN_LOAD(xb, 16);
#pragma unroll 1
    for (int cb = 0; cb < 128; cb += 32) {
        SCAN_STEP(xa); if (cb + 32 < 128) SCAN_LOAD(xa, cb + 32); SCAN_STORE(cb);
        SCAN_STEP(xb); if (cb + 48 < 128) SCAN_LOAD(xb, cb + 48); SCAN_STORE(cb + 16);
    }
#undef SCAN_STORE
#undef SCAN_LOAD
#undef SCAN_STEP
}

struct Args { const float* in[40]; float* out; unsigned char* ws; int lo, hi; };

__global__ void __launch_bounds__(512, 2) hybrid_fwd(Args a) {
    extern __shared__ __attribute__((aligned(16))) unsigned char lds_raw[];
    LAS unsigned char* lds = (LAS unsigned char*)lds_raw;
    LAS float* ldsf = (LAS float*)lds_raw;
    cg::grid_group grid = cg::this_grid();
    const int tid = threadIdx.x, lane = tid & 63, wave = __builtin_amdgcn_readfirstlane(tid >> 6);
    const int G = gridDim.x, bid = blockIdx.x;
    const int gw = bid * 8 + wave, NGW = G * 8;
    const int lo = a.lo, hi = a.hi;
    unsigned char* ws = a.ws;
    bf16_t* Wgu1 = (bf16_t*)(ws + WS_WGU1); bf16_t* Wd1 = (bf16_t*)(ws + WS_WD1); bf16_t* Wgu2 = (bf16_t*)(ws + WS_WGU2); bf16_t* Wd2 = (bf16_t*)(ws + WS_WD2);
    bf16_t* Win = (bf16_t*)(ws + WS_WIN); bf16_t* Wglu = (bf16_t*)(ws + WS_WGLU); bf16_t* Wout = (bf16_t*)(ws + WS_WOUT);
    bf16_t* B2 = (bf16_t*)(ws + WS_B2); bf16_t* Wst = (bf16_t*)(ws + WS_WST); float* Ktab = (float*)(ws + WS_KTAB); float* adec = (float*)(ws + WS_ADEC);
    bf16_t* U = (bf16_t*)(ws + WS_U); bf16_t* F = (bf16_t*)(ws + WS_F); bf16_t* ACT = (bf16_t*)(ws + WS_ACT);
    bf16_t* GC = (bf16_t*)(ws + WS_GC); bf16_t* A2 = (bf16_t*)(ws + WS_A2); float* X = (float*)(ws + WS_X); bf16_t* YG = (bf16_t*)(ws + WS_YG);
    bf16_t* CAT = U;
    bf16_t* HB = (bf16_t*)(ws + WS_HB);
#define IN(k) (lo <= (k) && (k) < hi)
    volatile LAS unsigned* bst = (volatile LAS unsigned*)(lds + LDS_CTL);
    LAS TrDesc* desc = (LAS TrDesc*)(lds + LDS_CTL + 64);
    constexpr int I_G = (D / 64) * (DFF / 32), I_D = (DFF / 64) * (D / 32), I_IN = (D / 64) * (DIN / 32), I_GLU = (DS / 64) * (DS / 32), I_O = (D / 64) * (D / 32);
    constexpr int C0 = I_G, C1 = C0 + I_G, C2 = C1 + I_D, C3 = C2 + I_IN, C4 = C3 + I_G, C5 = C4 + I_G, C6 = C5 + I_D, C7 = C6 + I_GLU, C8 = C7 + I_O;
    if (tid == 0) { bst[0] = 0u; bst[1] = 0u;
        set_desc(desc + 0, a.in[2], (bf16_t*)(ws + WS_WGU1), D, DFF, 1, C0, a.in[1]);  set_desc(desc + 1, a.in[3], (bf16_t*)(ws + WS_WGU1), D, DFF, 2, C1, a.in[1]);  set_desc(desc + 2, a.in[4], (bf16_t*)(ws + WS_WD1), DFF, D, 0, C2);
        set_desc(desc + 3, a.in[7], (bf16_t*)(ws + WS_WIN), D, DIN, 3, C3, a.in[6]);
        set_desc(desc + 4, a.in[36], (bf16_t*)(ws + WS_WGU2), D, DFF, 1, C4, a.in[35]); set_desc(desc + 5, a.in[37], (bf16_t*)(ws + WS_WGU2), D, DFF, 2, C5, a.in[35]);
        set_desc(desc + 6, a.in[38], (bf16_t*)(ws + WS_WD2), DFF, D, 0, C6); set_desc(desc + 7, a.in[29], (bf16_t*)(ws + WS_WGLU), DS, DS, 4, C7); set_desc(desc + 8, a.in[32], (bf16_t*)(ws + WS_WOUT), D, D, 0, C8); }
    __syncthreads();
    XcdBarrier xbar; xbar.bar = (unsigned*)(ws + WS_BAR); xbar.x = 0; xbar.st = bst;
    if (hi - lo > 1) xbar = xcd_barrier_post((unsigned*)(ws + WS_BAR), bst);
#ifndef CG_SEAM
#define CG_SEAM 0
#endif
    if (hi > NPH) grid.sync();
#define SEAM(k) do { if (IN(k) && IN((k) + 1)) xcd_barrier(xbar); } while (0)

#define TAIL_VARS const bool tailwg = (G == 256) ? (bid >= 128) : true; const int tgw = (G == 256) ? (bid - 128) * 8 + wave : gw, TNGW = (G == 256) ? 128 * 8 : NGW; const int tb = (G == 256) ? bid - 128 : bid, TG = (G == 256) ? 128 : G; LAS float* scr = ldsf + wave * (64 * 33)
    if (IN(0)) {
#pragma unroll 1
        for (int pass = 0; pass < 3; ++pass) {
            if (pass == 1) {
                tr_range(desc, 0, 0, C1, gw, NGW, ldsf + wave * (64 * 33), lane);
                norm_rows(a.in[0], (float*)(ws + WS_SS) + 5 * T, U, gw, NGW, lane);
                __syncthreads();
            } else if ((pass == 0) == ((bid & 1) != 0)) {
                for (int it = bid; it < 256; it += G) {
                    const int gd = it >> 2, jq = it & 3, g = gd >> 1, dir = gd & 1;
                    const SsmIn si{dir ? a.in[21] : a.in[14], dir ? a.in[22] : a.in[15], dir ? a.in[23] : a.in[16], dir ? a.in[24] : a.in[17], dir ? a.in[25] : a.in[18], dir ? a.in[26] : a.in[19], dir ? a.in[27] : a.in[20]};
                    ssm_tables_item(si, g, dir, jq, Ktab, Wst, B2, adec, ldsf, tid);
                }
            }
        }
    }
    SEAM(0);
    if (IN(1)) {
        pg8::Gemm g{U, Wgu1, D, D, D}; pg8::Sched S; S.init(0, T, 2 * DFF, G, bid);
        const float* SSx = (const float*)(ws + WS_SS) + 5 * T;
        LAS float* rtab = (LAS float*)(lds + pg8::STAGE_BYTES);
        pg8::Unit u0; const int pm0 = S.next(0, u0) ? u0.pm : -1;
        if (pm0 >= 0 && tid < 256) rtab[tid] = __builtin_amdgcn_rsqf(SSx[pm0 * 256 + tid] * (1.0f / D) + EPS);
        __syncthreads();
        pg8::EpiSwiGLU E{ACT, DFF, SSx, rtab, pm0};
        pg8::gemm_phase(lds, g, S, E);
        TAIL_VARS;
        if (tailwg) tr_range(desc, 2, C1, C3, tgw, TNGW, scr, lane);
    }
    SEAM(1);
    float* SS = (float*)(ws + WS_SS);
    if (IN(2)) {
        pg8::Gemm g{ACT, Wd1, DFF, DFF, DFF}; pg8::Sched S; S.init(0, T, D, G, bid);
        pg8::EpiNormRes E{nullptr, U, 0.5f, a.in[5], nullptr, SS, SS + T, HB, nullptr, &xbar};
        pg8::gemm_phase(lds, g, S, E);
    }
    SEAM(2);
    if (IN(4)) {
        pg8::Gemm g{HB, Win, D, D, D}; pg8::Sched S; S.init(0, T, DIN, G, bid);
        LAS float* rtab = (LAS float*)(lds + pg8::STAGE_BYTES);
        pg8::Unit u0; const int pm0 = S.next(0, u0) ? u0.pm : -1;
        if (pm0 >= 0 && tid < 256) rtab[tid] = __builtin_amdgcn_rsqf(SS[T + pm0 * 256 + tid] * (1.0f / D) + EPS);
        LAS float* lbias = rtab + 256;
        for (int i = tid; i < DIN; i += 512) lbias[i] = a.in[8][i];
        __syncthreads();
        pg8::EpiWin E{GC, A2, lbias, SS + T, rtab, pm0};
        pg8::gemm_phase(lds, g, S, E);
        TAIL_VARS;
        if (tailwg) {
            tr_range(desc, 4, C3, C5, tgw, TNGW, scr, lane);
            toeplitz_items(Ktab, a.in[28], B2, tb * 512 + tid, TG * 512);
        }
    }
    SEAM(4);
    if (IN(5)) {
        if (bid < 64) {
            pg8::Gemm g{A2, Wst, 768, 512, 512}; pg8::Sched S; S.init(1, 0, 0, 64, bid);
            pg8::EpiXScan E{lds, adec, A2};
            pg8::gemm_phase(lds, g, S, E);
        } else {
            for (int tile = bid - 64; tile < 384; tile += G - 64) conv_tile(GC, a.in[9], a.in[10], a.in[11], a.in[12], a.in[13], CAT, ldsf, tile, tid, lane, wave);
        }
    }
    SEAM(6);
    if (IN(7)) {
        pg8::Gemm g{A2, B2, 768, 768, 768}; pg8::Sched S; S.init(2, 0, 0, G, bid);
        pg8::EpiS2 E{YG};
        pg8::gemm_phase(lds, g, S, E);
        TAIL_VARS;
        if (G == 256 && bid >= 128) conv_tile(GC, a.in[9], a.in[10], a.in[11], a.in[12], a.in[13], CAT, ldsf, 384 + bid - 128, tid, lane, wave);
        if (tailwg) tr_range(desc, 6, C5, C8, tgw, TNGW, scr, lane);
    }
    SEAM(7);
    if (IN(8)) {
        pg8::Gemm g{YG, Wglu, DS, DS, DS}; pg8::Sched S; S.init(0, T, DS, G, bid);
        pg8::EpiGlu E{YG, CAT, a.in[30], a.in[31]};
        pg8::gemm_phase(lds, g, S, E);
    }
    SEAM(8);
    if (IN(9)) {
        pg8::Gemm g{CAT, Wout, D, D, D}; pg8::Sched S; S.init(0, T, D, G, bid);
        pg8::EpiNormRes E{nullptr, HB, 1.0f, a.in[34], a.in[33], SS + 2 * T, SS + 3 * T, HB, nullptr, &xbar};
        pg8::gemm_phase(lds, g, S, E);
    }
    SEAM(9);
    if (IN(11)) {
        pg8::Gemm g{HB, Wgu2, D, D, D}; pg8::Sched S; S.init(0, T, 2 * DFF, G, bid);
        LAS float* rtab = (LAS float*)(lds + pg8::STAGE_BYTES);
        pg8::Unit u0; const int pm0 = S.next(0, u0) ? u0.pm : -1;
        if (pm0 >= 0 && tid < 256) rtab[tid] = __builtin_amdgcn_rsqf(SS[3 * T + pm0 * 256 + tid] * (1.0f / D) + EPS);
        __syncthreads();
        pg8::EpiSwiGLU E{ACT, DFF, SS + 3 * T, rtab, pm0};
        pg8::gemm_phase(lds, g, S, E);
    }
    SEAM(11);
    if (IN(12)) {
        pg8::Gemm g{ACT, Wd2, DFF, DFF, DFF}; pg8::Sched S; S.init(0, T, D, G, bid);
        pg8::EpiNormRes E{nullptr, HB, 0.5f, a.in[39], nullptr, SS + 4 * T, nullptr, nullptr, a.out, &xbar};
        pg8::gemm_phase(lds, g, S, E);
    }
#undef IN
#undef SEAM
}

extern "C" void kernel_launch(void* const* d_in, const int* in_sizes, int n_in, void* d_out, int out_size, void* d_ws, size_t ws_size, hipStream_t stream) {
    constexpr int LDS_BYTES = LDS_CTL + 512;
    static int grid = 0;
    if (grid == 0) {
        int dev = 0, cus = 0, per_cu = 0;
        if (n_in != 40 || ws_size < WS_END) { fprintf(stderr, "kernel_launch: unexpected n_in %d / ws_size %zu (need %zu)\n", n_in, ws_size, (size_t)WS_END); grid = -1; return; }
        hipGetDevice(&dev);
        hipDeviceGetAttribute(&cus, hipDeviceAttributeMultiprocessorCount, dev);
        if (hipFuncSetAttribute((const void*)hybrid_fwd, hipFuncAttributeMaxDynamicSharedMemorySize, LDS_BYTES) != hipSuccess) { fprintf(stderr, "kernel_launch: hipFuncSetAttribute failed\n"); grid = -1; return; }
        if (hipOccupancyMaxActiveBlocksPerMultiprocessor(&per_cu, (const void*)hybrid_fwd, 512, LDS_BYTES) != hipSuccess || per_cu < 1) { fprintf(stderr, "kernel_launch: occupancy query failed (%d)\n", per_cu); (void)hipGetLastError(); per_cu = 1; }
        if (cus != 256) { fprintf(stderr, "kernel_launch: built for a 256-CU device (one 256x256 unit per workgroup in the fused-norm GEMM phases); got %d CUs\n", cus); grid = -1; return; }
        grid = cus * 1;
        if (grid <= 0) grid = 256;
    }
    if (grid < 0) return;
    if (hipMemsetAsync((unsigned char*)d_ws + WS_BAR, 0, ZERO_BYTES, stream) != hipSuccess) { fprintf(stderr, "kernel_launch: hipMemsetAsync failed\n"); return; }
    Args a{};
    for (int i = 0; i < 40; ++i) a.in[i] = (const float*)d_in[i];
    a.out = (float*)d_out; a.ws = (unsigned char*)d_ws;
    a.lo = 0; a.hi = NPH;
    void* args[] = {&a};
    hipError_t e = hipLaunchCooperativeKernel((const void*)hybrid_fwd, dim3(grid), dim3(512), args, LDS_BYTES, stream);
    if (e != hipSuccess) fprintf(stderr, "kernel_launch: cooperative launch failed: %s (grid %d)\n", hipGetErrorString(e), grid);
}
```
